# Optimizing an MI355X kernel written in HIP

```python
import math
import jax, jax.numpy as jnp
from jax import lax
import numpy as np

D_MODEL = 1024
BATCH = 8
SEQ = 8192
DEPTH = 2

HEAD_DIM = 64
ROPE_THETA = 500000.0
ROT_DIM = HEAD_DIM // 4
Q_BLOCK = 128
NEG_INF = -1e30

DIFF_HEADS = 4
DIFF_QK_DIM = HEAD_DIM
DIFF_V_DIM = 2 * HEAD_DIM
MLA_HEADS = 8
MLA_Q_RANK = 384
MLA_KV_RANK = 256
MLA_NOPE_DIM = 64
MLA_ROPE_DIM = 32
MLA_V_DIM = 64
DIL_PATTERNS = ((128, 1), (512, 4), (2048, 16))
DIL_GROUPS = len(DIL_PATTERNS)
DIL_HEADS = 4
DIL_QK_DIM = HEAD_DIM
DIL_V_DIM = 2 * HEAD_DIM
BRANCH_A = DIFF_HEADS * DIFF_V_DIM
BRANCH_B = MLA_HEADS * MLA_V_DIM
BRANCH_C = DIL_HEADS * DIL_V_DIM
N_BRANCHES = 3
IN_SIZES = (DIFF_HEADS * 2 * DIFF_QK_DIM, DIFF_HEADS * 2 * DIFF_QK_DIM, DIFF_HEADS * DIFF_V_DIM,
            MLA_Q_RANK, MLA_KV_RANK, MLA_ROPE_DIM,
            DIL_GROUPS * DIL_HEADS * DIL_QK_DIM, DIL_GROUPS * DIL_HEADS * DIL_QK_DIM,
            DIL_GROUPS * DIL_HEADS * DIL_V_DIM,
            N_BRANCHES * D_MODEL)
IN_SPLITS = tuple(int(v) for v in np.cumsum(IN_SIZES)[:-1])
IN_WIDTH = int(sum(IN_SIZES))
N_EXPERTS = 16
N_EXPERT_GROUPS = 4
EXPERTS_PER_GROUP = N_EXPERTS // N_EXPERT_GROUPS
TOPK_GROUPS = 1
TOP_K = 2
EXPERT_HIDDEN = 256
SHARED_HIDDEN = 256
DEEPNORM_ALPHA = (2 * DEPTH) ** 0.25
DEEPNORM_BETA = (8 * DEPTH) ** -0.25

kernel_name = 'hybrid_diff_mla_dilated_moe_encoder'

f32 = jnp.float32


def layer_norm(x, g, b, eps=1e-5):
    xf = x.astype(f32)
    mu = xf.mean(-1, keepdims=True)
    var = jnp.square(xf - mu).mean(-1, keepdims=True)
    return ((xf - mu) * lax.rsqrt(var + eps) * g.astype(f32) + b.astype(f32)).astype(x.dtype)


def rms_norm(x, g, eps=1e-6):
    xf = x.astype(f32)
    return (xf * lax.rsqrt(jnp.mean(xf * xf, -1, keepdims=True) + eps) * g.astype(f32)).astype(x.dtype)


def rope_tables(positions, dim):
    inv_freq = ROPE_THETA ** (-jnp.arange(0, dim, 2, dtype=f32) / dim)
    ang = positions.astype(f32)[..., None] * inv_freq
    return jnp.cos(ang)[:, :, None, :], jnp.sin(ang)[:, :, None, :]


def apply_rope(x, cos, sin):
    x1, x2 = jnp.split(x.astype(f32), 2, axis=-1)
    return jnp.concatenate([x1 * cos - x2 * sin, x2 * cos + x1 * sin], axis=-1).astype(x.dtype)


def partial_rope(x, cos, sin):
    r = 2 * cos.shape[-1]
    return jnp.concatenate([apply_rope(x[..., :r], cos, sin), x[..., r:]], axis=-1)


def _to_blocks(t):
    b, s = t.shape[:2]
    return jnp.swapaxes(t.reshape(b, s // Q_BLOCK, Q_BLOCK, *t.shape[2:]), 0, 1)


def _from_blocks(t):
    t = jnp.swapaxes(t, 0, 1)
    return t.reshape(t.shape[0], -1, *t.shape[3:])


def diff_attention(q, k, v, lam):
    scale = q.shape[-1] ** -0.5

    def block(qb):
        s = jnp.einsum('bqhmd,bkhmd->bhmqk', qb, k).astype(f32) * scale
        p = jax.nn.softmax(s, axis=-1)
        a = p[:, :, 0] - lam * p[:, :, 1]
        return jnp.einsum('bhqk,bkhe->bqhe', a.astype(v.dtype), v)

    return _from_blocks(lax.map(block, _to_blocks(q)))


def mla_attention(q_nope, q_rope, k_nope, k_rope, v):
    scale = (q_nope.shape[-1] + q_rope.shape[-1]) ** -0.5

    def block(qs):
        qn, qr = qs
        s = (jnp.einsum('bqhd,bkhd->bhqk', qn, k_nope)
             + jnp.einsum('bqhr,bkr->bhqk', qr, k_rope)).astype(f32) * scale
        p = jax.nn.softmax(s, axis=-1)
        return jnp.einsum('bhqk,bkhe->bqhe', p.astype(v.dtype), v)

    return _from_blocks(lax.map(block, (_to_blocks(q_nope), _to_blocks(q_rope))))


def _to_sub(t, d):
    b, s = t.shape[:2]
    rest = t.shape[2:]
    return jnp.swapaxes(t.reshape(b, s // d, d, *rest), 1, 2).reshape(b * d, s // d, *rest)


def _from_sub(t, b, d):
    l = t.shape[1]
    rest = t.shape[2:]
    return jnp.swapaxes(t.reshape(b, d, l, *rest), 1, 2).reshape(b, l * d, *rest)


def dilated_window_attention(q, k, v, dilation, n_side):
    b, s, h, dk = q.shape
    L = s // dilation
    nb = -(-L // n_side)
    lp = nb * n_side
    bd = b * dilation
    qs, ks, vs = (_to_sub(t, dilation) for t in (q, k, v))
    qs = jnp.pad(qs, ((0, 0), (0, lp - L), (0, 0), (0, 0))).reshape(bd, nb, n_side, h, dk)

    def band(t):
        tp = jnp.pad(t, ((0, 0), (n_side, lp - L + n_side), (0, 0), (0, 0)))
        tp = tp.reshape(bd, nb + 2, n_side, h, t.shape[-1])
        return jnp.concatenate([tp[:, :-2], tp[:, 1:-1], tp[:, 2:]], axis=2)

    kb, vb = band(ks), band(vs)
    scores = jnp.einsum('bnqhd,bnkhd->bnhqk', qs, kb).astype(f32) * dk ** -0.5
    qi = jnp.arange(n_side)[:, None]
    kc = jnp.arange(3 * n_side)[None, :]
    in_band = jnp.abs(kc - n_side - qi) <= n_side
    kpos = jnp.arange(nb)[:, None] * n_side - n_side + kc
    valid = (kpos >= 0) & (kpos < L)
    mask = in_band[None] & valid[:, None]
    scores = jnp.where(mask[None, :, None], scores, NEG_INF)
    lse = jax.nn.logsumexp(scores, axis=-1)
    p = jnp.exp(scores - lse[..., None])
    o = jnp.einsum('bnhqk,bnkhe->bnqhe', p.astype(v.dtype), vb).reshape(bd, lp, h, -1)[:, :L]
    lse = jnp.swapaxes(lse, 2, 3).reshape(bd, lp, h)[:, :L]
    return _from_sub(o, b, dilation), _from_sub(lse, b, dilation)


def hybrid_mixer(x, layer, cos_p, sin_p, cos_m, sin_m, w_in, b_gate, lam_q1, lam_k1, lam_q2, lam_k2,
                 diff_norm_g, q_norm_g, kv_norm_g, w_qb, w_kvb, w_br_a, w_br_b, w_br_c, w_out):
    B, S, D = x.shape
    h = x @ w_in
    a_q, a_k, a_v, b_cq, b_ckv, b_kr, c_q, c_k, c_v, g = jnp.split(h, IN_SPLITS, axis=-1)

    aq = partial_rope(a_q.reshape(B, S, DIFF_HEADS * 2, DIFF_QK_DIM), cos_p, sin_p)
    ak = partial_rope(a_k.reshape(B, S, DIFF_HEADS * 2, DIFF_QK_DIM), cos_p, sin_p)
    aq = aq.reshape(B, S, DIFF_HEADS, 2, DIFF_QK_DIM)
    ak = ak.reshape(B, S, DIFF_HEADS, 2, DIFF_QK_DIM)
    av = a_v.reshape(B, S, DIFF_HEADS, DIFF_V_DIM)
    lam_init = 0.8 - 0.6 * math.exp(-0.3 * layer)
    lam = (jnp.exp(jnp.sum(lam_q1.astype(f32) * lam_k1.astype(f32)))
           - jnp.exp(jnp.sum(lam_q2.astype(f32) * lam_k2.astype(f32))) + lam_init)
    out_a = diff_attention(aq, ak, av, lam)
    out_a = (rms_norm(out_a, diff_norm_g) * (1.0 - lam_init)).reshape(B, S, BRANCH_A)

    q_full = (rms_norm(b_cq, q_norm_g) @ w_qb).reshape(B, S, MLA_HEADS, MLA_NOPE_DIM + MLA_ROPE_DIM)
    q_nope, q_rope = q_full[..., :MLA_NOPE_DIM], apply_rope(q_full[..., MLA_NOPE_DIM:], cos_m, sin_m)
    kv = (rms_norm(b_ckv, kv_norm_g) @ w_kvb).reshape(B, S, MLA_HEADS, MLA_NOPE_DIM + MLA_V_DIM)
    k_nope, v_b = kv[..., :MLA_NOPE_DIM], kv[..., MLA_NOPE_DIM:]
    k_rope = apply_rope(b_kr[:, :, None, :], cos_m, sin_m)[:, :, 0]
    out_b = mla_attention(q_nope, q_rope, k_nope, k_rope, v_b).reshape(B, S, BRANCH_B)

    cq = partial_rope(c_q.reshape(B, S, DIL_GROUPS * DIL_HEADS, DIL_QK_DIM), cos_p, sin_p)
    ck = partial_rope(c_k.reshape(B, S, DIL_GROUPS * DIL_HEADS, DIL_QK_DIM), cos_p, sin_p)
    cq = cq.reshape(B, S, DIL_GROUPS, DIL_HEADS, DIL_QK_DIM)
    ck = ck.reshape(B, S, DIL_GROUPS, DIL_HEADS, DIL_QK_DIM)
    cv = c_v.reshape(B, S, DIL_GROUPS, DIL_HEADS, DIL_V_DIM)
    outs, lses = [], []
    for gi, (window, dilation) in enumerate(DIL_PATTERNS):
        o, lse = dilated_window_attention(cq[:, :, gi], ck[:, :, gi], cv[:, :, gi],
                                          dilation, (window // 2) // dilation)
        outs.append(o)
        lses.append(lse)
    w_grp = jax.nn.softmax(jnp.stack(lses, axis=-1), axis=-1)
    out_c = jnp.einsum('bshg,bshge->bshe', w_grp, jnp.stack(outs, axis=3).astype(f32))
    out_c = out_c.astype(x.dtype).reshape(B, S, BRANCH_C)

    gates = jax.nn.sigmoid((g + b_gate).astype(f32)).astype(x.dtype).reshape(B, S, N_BRANCHES, D)
    y = (gates[:, :, 0] * (out_a @ w_br_a) + gates[:, :, 1] * (out_b @ w_br_b)
         + gates[:, :, 2] * (out_c @ w_br_c))
    return y @ w_out


def moe_ffn(x, router_w, router_bias, w_g, w_u, w_d, w_sg, w_su, w_sd):
    B, S, D = x.shape
    xt = x.reshape(-1, D)
    scores = jax.nn.sigmoid((xt @ router_w).astype(f32))
    biased = scores + router_bias.astype(f32)
    grp = biased.reshape(-1, N_EXPERT_GROUPS, EXPERTS_PER_GROUP)
    grp_score = lax.top_k(grp, 2)[0].sum(-1)
    gsel = lax.top_k(grp_score, TOPK_GROUPS)[1]
    gmask = jax.nn.one_hot(gsel, N_EXPERT_GROUPS, dtype=f32).sum(1) > 0
    emask = jnp.repeat(gmask, EXPERTS_PER_GROUP, axis=-1)
    eidx = lax.top_k(jnp.where(emask, biased, -jnp.inf), TOP_K)[1]
    wsel = jnp.take_along_axis(scores, eidx, axis=-1)
    wsel = wsel / wsel.sum(-1, keepdims=True)
    gate = (jax.nn.one_hot(eidx, N_EXPERTS, dtype=f32) * wsel[..., None]).sum(1)
    routed = jnp.zeros(xt.shape, f32)
    for e in range(N_EXPERTS):
        hid = jax.nn.silu(xt @ w_g[e]) * (xt @ w_u[e])
        routed = routed + gate[:, e:e + 1] * (hid @ w_d[e]).astype(f32)
    shared = (jax.nn.silu(xt @ w_sg) * (xt @ w_su)) @ w_sd
    return (routed.astype(x.dtype) + shared).reshape(B, S, D)


def setup_inputs(seed: int = 0) -> dict:
    key = jax.random.key(seed)
    ks = iter(jax.random.split(key, 40))

    def nrm(shape, scale):
        return scale * jax.random.normal(next(ks), shape, f32)

    def gain(shape):
        return 1.0 + nrm(shape, 0.02)

    L, D = DEPTH, D_MODEL
    x = jax.random.normal(next(ks), (BATCH, SEQ, D), f32)
    offset = jax.random.randint(next(ks), (BATCH, 1), 0, 65536)
    positions = (offset + jnp.arange(SEQ)[None, :]).astype(jnp.int32)
    return {
        'x': x,
        'positions': positions,
        'ln_in_g': gain((D,)),
        'ln_in_b': nrm((D,), 0.02),
        'w_in': nrm((L, D, IN_WIDTH), D ** -0.5),
        'b_gate': nrm((L, N_BRANCHES * D), 0.1),
        'lam_q1': nrm((L, DIFF_QK_DIM), 0.1),
        'lam_k1': nrm((L, DIFF_QK_DIM), 0.1),
        'lam_q2': nrm((L, DIFF_QK_DIM), 0.1),
        'lam_k2': nrm((L, DIFF_QK_DIM), 0.1),
        'diff_norm_g': gain((L, DIFF_V_DIM)),
        'mla_q_norm_g': gain((L, MLA_Q_RANK)),
        'mla_kv_norm_g': gain((L, MLA_KV_RANK)),
        'w_mla_qb': nrm((L, MLA_Q_RANK, MLA_HEADS * (MLA_NOPE_DIM + MLA_ROPE_DIM)), MLA_Q_RANK ** -0.5),
        'w_mla_kvb': nrm((L, MLA_KV_RANK, MLA_HEADS * (MLA_NOPE_DIM + MLA_V_DIM)), MLA_KV_RANK ** -0.5),
        'w_branch_a': nrm((L, BRANCH_A, D), BRANCH_A ** -0.5),
        'w_branch_b': nrm((L, BRANCH_B, D), BRANCH_B ** -0.5),
        'w_branch_c': nrm((L, BRANCH_C, D), BRANCH_C ** -0.5),
        'w_out': nrm((L, D, D), D ** -0.5 * DEEPNORM_BETA),
        'ln1_g': gain((L, D)),
        'ln1_b': nrm((L, D), 0.02),
        'router_w': nrm((D, N_EXPERTS), D ** -0.5),
        'router_bias': nrm((N_EXPERTS,), 0.01),
        'w_exp_gate': nrm((L, N_EXPERTS, D, EXPERT_HIDDEN), D ** -0.5),
        'w_exp_up': nrm((L, N_EXPERTS, D, EXPERT_HIDDEN), D ** -0.5),
        'w_exp_down': nrm((L, N_EXPERTS, EXPERT_HIDDEN, D), EXPERT_HIDDEN ** -0.5 * DEEPNORM_BETA),
        'w_sh_gate': nrm((L, D, SHARED_HIDDEN), D ** -0.5),
        'w_sh_up': nrm((L, D, SHARED_HIDDEN), D ** -0.5),
        'w_sh_down': nrm((L, SHARED_HIDDEN, D), SHARED_HIDDEN ** -0.5 * DEEPNORM_BETA),
        'ln2_g': gain((L, D)),
        'ln2_b': nrm((L, D), 0.02),
    }


def reference(x, positions, ln_in_g, ln_in_b, w_in, b_gate, lam_q1, lam_k1, lam_q2, lam_k2,
              diff_norm_g, mla_q_norm_g, mla_kv_norm_g, w_mla_qb, w_mla_kvb, w_branch_a, w_branch_b,
              w_branch_c, w_out, ln1_g, ln1_b, router_w, router_bias, w_exp_gate, w_exp_up,
              w_exp_down, w_sh_gate, w_sh_up, w_sh_down, ln2_g, ln2_b):
    cos_p, sin_p = rope_tables(positions, ROT_DIM)
    cos_m, sin_m = rope_tables(positions, MLA_ROPE_DIM)
    x = layer_norm(x, ln_in_g, ln_in_b)
    for l in range(DEPTH):
        mix = hybrid_mixer(x, l, cos_p, sin_p, cos_m, sin_m, w_in[l], b_gate[l],
                           lam_q1[l], lam_k1[l], lam_q2[l], lam_k2[l], diff_norm_g[l],
                           mla_q_norm_g[l], mla_kv_norm_g[l], w_mla_qb[l], w_mla_kvb[l],
                           w_branch_a[l], w_branch_b[l], w_branch_c[l], w_out[l])
        x = layer_norm(DEEPNORM_ALPHA * x + mix, ln1_g[l], ln1_b[l])
        ffn = moe_ffn(x, router_w, router_bias, w_exp_gate[l], w_exp_up[l], w_exp_down[l],
                      w_sh_gate[l], w_sh_up[l], w_sh_down[l])
        x = layer_norm(DEEPNORM_ALPHA * x + ffn, ln2_g[l], ln2_b[l])
    return x
```

```cpp
#include <hip/hip_runtime.h>
#include <cstdio>
#include <cstdint>
#include <cmath>
#include <cstring>

#define LAS __attribute__((address_space(3)))
#define GAS __attribute__((address_space(1)))
typedef unsigned short bf16_t;
typedef short bf16x8 __attribute__((ext_vector_type(8)));
typedef short s16x4 __attribute__((ext_vector_type(4)));
typedef float f32x4 __attribute__((ext_vector_type(4)));
typedef float f32x2 __attribute__((ext_vector_type(2)));
typedef float f32x16 __attribute__((ext_vector_type(16)));
typedef unsigned u32x4 __attribute__((ext_vector_type(4)));
typedef unsigned u32x2 __attribute__((ext_vector_type(2)));

__device__ __forceinline__ void st128(void* p, u32x4 v) { asm volatile("global_store_dwordx4 %0, %1, off sc0 sc1\n\ts_nop 2" :: "v"((GAS void*)p), "v"(v) : "memory"); }
__device__ __forceinline__ void st128f(void* p, f32x4 v) { asm volatile("global_store_dwordx4 %0, %1, off sc0 sc1\n\ts_nop 2" :: "v"((GAS void*)p), "v"(v) : "memory"); }
__device__ __forceinline__ void st64(void* p, u32x2 v) { asm volatile("global_store_dwordx2 %0, %1, off sc0 sc1" :: "v"((GAS void*)p), "v"(v) : "memory"); }
__device__ __forceinline__ void st32(void* p, unsigned v) { asm volatile("global_store_dword %0, %1, off sc0 sc1" :: "v"((GAS void*)p), "v"(v) : "memory"); }
__device__ __forceinline__ void st32f(void* p, float v) { asm volatile("global_store_dword %0, %1, off sc0 sc1" :: "v"((GAS void*)p), "v"(v) : "memory"); }
__device__ __forceinline__ void st16(void* p, unsigned v) { asm volatile("global_store_short %0, %1, off sc0 sc1" :: "v"((GAS void*)p), "v"(v) : "memory"); }

constexpr int D = 1024, BATCH = 8, SEQ = 8192, DEPTH = 2, TT = BATCH * SEQ;
constexpr int NBC = 4;
constexpr int TC = NBC * SEQ;
constexpr int NCHUNK = BATCH / NBC;
constexpr int IN_WIDTH = 8352;
constexpr int NIN_A = 5376;
constexpr int NIN_T = 8448;
constexpr int NEXP = 16;
constexpr float LN_EPS = 1e-5f, RMS_EPS = 1e-6f;
constexpr float ALPHA = 1.4142135623730951f;
constexpr float LOG2E = 1.4426950408889634f;

namespace pg8 {
constexpr int BM = 256, BK = 64, HALF = 128, HTB = HALF * BK * 2, STAGE_BYTES = 8 * HTB;
__host__ __device__ __forceinline__ int lds_byte(int r, int c) { const int st = (r >> 4) * 2 + (c >> 5), rr = r & 15, cc = c & 31, ob = rr * 64 + cc * 2; return st * 1024 + (ob ^ (((ob >> 9) & 1) << 5)); }
__host__ __device__ __forceinline__ void stage_rc(int b, int& R, int& C) { const int st = b / 1024, sb = b % 1024, swz = sb ^ (((sb >> 9) & 1) << 5); R = (st >> 1) * 16 + swz / 64; C = (st & 1) * 32 + (swz % 64) / 2; }
__host__ __device__ __forceinline__ int perm32(int rho) { const int n = rho >> 4, i = rho & 15; return 8 * (i >> 2) + 4 * n + (i & 3); }
struct Unit { int pm, pn; };
struct Gemm { const bf16_t* A; const bf16_t* Bt; int lda, ldb, K; };

struct StaticOrder {
    int nM, nN, nwg, G, c;
    __device__ void init(int M, int N, int G_, int c_) { nM = M / BM; nN = N / BM; nwg = nM * nN; G = G_; c = c_; }
    __device__ bool next(int i, Unit& u) const {
        const long L = (long)i * G + c; if (L >= nwg) return false;
        int wgid = (int)L; { const int q = nwg / 8, r = nwg % 8, xcd = wgid % 8, off = wgid / 8; wgid = (xcd < r ? xcd * (q + 1) : r * (q + 1) + (xcd - r) * q) + off; }
        const int nig = 8 * nN, gid = wgid / nig, fm = gid * 8, gsz = (nM - fm) < 8 ? (nM - fm) : 8;
        u.pm = fm + ((wgid % nig) % gsz); u.pn = (wgid % nig) / gsz; return true;
    }
};

__device__ __forceinline__ unsigned cvt_pk_bf16(float lo, float hi) { unsigned r; asm volatile("v_cvt_pk_bf16_f32 %0, %1, %2" : "=v"(r) : "v"(lo), "v"(hi)); return r; }

template <class Epi, class Sched, bool GATHER = false>
__device__ __forceinline__ void gemm_phase(LAS unsigned char* lds, const int tid, const Gemm g, const Sched& S, const Epi& E, const int* gtab = nullptr) {
    const int wid = __builtin_amdgcn_readfirstlane(tid >> 6), lane = tid & 63, wr = wid >> 2, wc = wid & 3, fr = lane & 15, fq = lane >> 4;
    const int K = g.K, nt = K / BK;
    unsigned voffA[2], voffB[2];
#define PG8_GOFF(dst, pm_) do { const int sh_ = __builtin_ctz(g.lda * 2); _Pragma("unroll") for (int h_ = 0; h_ < 2; ++h_) _Pragma("unroll") for (int i_ = 0; i_ < 2; ++i_) { \
        const int r_ = gtab[(pm_) * 256 + h_ * 128 + (int)(voffA[i_] >> sh_)]; dst[h_][i_] = ((unsigned)(r_ < 0 ? 0 : (r_ & 0xffffff)) << sh_) + (voffA[i_] & ((1u << sh_) - 1u)); } } while (0)
#pragma unroll
    for (int i = 0; i < 2; ++i) { int R, C; stage_rc(tid * 16 + i * 8192, R, C); const int Rb = (R & ~31) + perm32(R & 31);
        voffA[i] = (unsigned)(R * g.lda + C) * 2u; voffB[i] = (unsigned)(Rb * g.ldb + C) * 2u; }
    const size_t kstep = (size_t)(BK * 2);
    const size_t hsA = (size_t)HALF * g.lda * 2, hsB = (size_t)HALF * g.ldb * 2;
    const size_t tsA = 2 * hsA, tsB = 2 * hsB;
    const unsigned ldsw = (unsigned)wid * 1024u;
    const int aoff = lds_byte(wr * 64 + fr, fq * 8), boff = lds_byte(wc * 32 + fr, fq * 8);
#define PG8_SA(b, h) (((b) * 2 + (h)) * HTB)
#define PG8_SB(b, h) ((4 + (b) * 2 + (h)) * HTB)
#define PG8_STAGE(bufoff, gbase, voff) do { _Pragma("unroll") for (int _i = 0; _i < 2; ++_i) \
        __builtin_amdgcn_global_load_lds((const unsigned*)((const char*)(gbase) + (voff)[_i]), (LAS unsigned*)(lds + (bufoff) + ldsw + _i * 8192), 16, 0, 0); } while (0)
#define PG8_STAGE_A(bufoff, base, h, GO) do { if constexpr (GATHER) PG8_STAGE(bufoff, base, GO[h]); else PG8_STAGE(bufoff, (base) + (h) * hsA, voffA); } while (0)
#define PG8_LDA(dst, b, h) do { _Pragma("unroll") for (int m = 0; m < 4; ++m) _Pragma("unroll") for (int k = 0; k < 2; ++k) dst[m][k] = *(const LAS bf16x8*)(lds + PG8_SA(b, h) + aoff + m * 2048 + k * 1024); } while (0)
#define PG8_LDB(dst, b, h) do { _Pragma("unroll") for (int n = 0; n < 2; ++n) _Pragma("unroll") for (int k = 0; k < 2; ++k) dst[n][k] = *(const LAS bf16x8*)(lds + PG8_SB(b, h) + boff + n * 2048 + k * 1024); } while (0)
#define PG8_MMA(ai, bj, At, Bt) do { __builtin_amdgcn_s_setprio(1); _Pragma("unroll") for (int m = 0; m < 4; ++m) _Pragma("unroll") for (int n = 0; n < 2; ++n) _Pragma("unroll") for (int k = 0; k < 2; ++k) \
        acc[ai][bj][m][n] = __builtin_amdgcn_mfma_f32_16x16x32_bf16(Bt[n][k], At[m][k], acc[ai][bj][m][n], 0, 0, 0); __builtin_amdgcn_s_setprio(0); } while (0)
#define PG8_WAIT_V(n) asm volatile("s_waitcnt vmcnt(" #n ")" ::: "memory")
#define PG8_WAIT_L(n) asm volatile("s_waitcnt lgkmcnt(" #n ")" ::: "memory")
#define PG8_BAR __builtin_amdgcn_s_barrier()
#define PG8_SCHED __builtin_amdgcn_sched_barrier(0)
    Unit cur, nxt; int ui = 0;
    if (!S.next(0, cur)) return;
    float zr = 0.f; asm volatile("" : "+v"(zr));
    f32x4 acc[2][2][4][2];
#pragma unroll
    for (int a = 0; a < 2; ++a)
#pragma unroll
        for (int b = 0; b < 2; ++b)
#pragma unroll
            for (int m = 0; m < 4; ++m)
#pragma unroll
                for (int n = 0; n < 2; ++n) acc[a][b][m][n] = (f32x4){zr, zr, zr, zr};
    bf16x8 At[4][2], B0[2][2], B1[2][2];
    const char* cA = GATHER ? (const char*)g.A : (const char*)g.A + (size_t)cur.pm * tsA; const char* cB = (const char*)g.Bt + (size_t)cur.pn * tsB;
    unsigned gC[2][2], gN[2][2]; if constexpr (GATHER) PG8_GOFF(gC, cur.pm);
    PG8_STAGE(PG8_SB(0, 0), cB, voffB); PG8_STAGE(PG8_SB(0, 1), cB + hsB, voffB); PG8_STAGE_A(PG8_SA(0, 0), cA, 0, gC); PG8_STAGE_A(PG8_SA(0, 1), cA, 1, gC);
    if (wr == 1) PG8_BAR;
    PG8_WAIT_V(2); PG8_BAR;
    PG8_STAGE(PG8_SB(1, 0), cB + kstep, voffB); PG8_STAGE_A(PG8_SA(1, 0), cA + kstep, 0, gC); PG8_STAGE(PG8_SB(1, 1), cB + hsB + kstep, voffB);
    PG8_WAIT_V(6); PG8_BAR;
    for (;;) {
        const bool has_next = S.next(ui + 1, nxt);
        const char* nA = GATHER ? (const char*)g.A : (has_next ? (const char*)g.A + (size_t)nxt.pm * tsA : cA); const char* nB = has_next ? (const char*)g.Bt + (size_t)nxt.pn * tsB : cB;

#pragma unroll 1
        for (int t = 0; t < nt; t += 2) {
            const bool last = (t == nt - 2);
            const char* a1 = cA + (size_t)(t + 1) * kstep;
            const char* a2 = last ? nA : cA + (size_t)(t + 2) * kstep; const char* b2 = last ? nB : cB + (size_t)(t + 2) * kstep;
            const char* a3 = a2 + kstep; const char* b3 = b2 + kstep;
            unsigned g2[2][2]; if constexpr (GATHER) { if (last && has_next) { PG8_GOFF(gN, nxt.pm); _Pragma("unroll") for (int h_ = 0; h_ < 2; ++h_) _Pragma("unroll") for (int i_ = 0; i_ < 2; ++i_) g2[h_][i_] = gN[h_][i_]; }
                else { _Pragma("unroll") for (int h_ = 0; h_ < 2; ++h_) _Pragma("unroll") for (int i_ = 0; i_ < 2; ++i_) g2[h_][i_] = gC[h_][i_]; } }
            PG8_LDB(B0, 0, 0); PG8_LDB(B1, 0, 1); PG8_SCHED; PG8_LDA(At, 0, 0); PG8_STAGE_A(PG8_SA(1, 1), a1, 1, gC);
            PG8_WAIT_V(8); PG8_WAIT_L(0); PG8_BAR; PG8_MMA(0, 0, At, B0); PG8_MMA(0, 1, At, B1); PG8_BAR; PG8_SCHED;
            PG8_LDA(At, 0, 1); PG8_STAGE(PG8_SB(0, 0), b2, voffB); PG8_STAGE(PG8_SB(0, 1), b2 + hsB, voffB); PG8_STAGE_A(PG8_SA(0, 0), a2, 0, g2);
            PG8_WAIT_V(8); PG8_WAIT_L(0); PG8_BAR; PG8_MMA(1, 0, At, B0); PG8_MMA(1, 1, At, B1); PG8_BAR; PG8_SCHED;
            PG8_LDB(B0, 1, 0); PG8_LDB(B1, 1, 1); PG8_SCHED; PG8_LDA(At, 1, 0); PG8_STAGE_A(PG8_SA(0, 1), a2, 1, g2);
            PG8_WAIT_V(8); PG8_WAIT_L(0); PG8_BAR; PG8_MMA(0, 0, At, B0); PG8_MMA(0, 1, At, B1); PG8_BAR; PG8_SCHED;
            PG8_LDA(At, 1, 1); PG8_STAGE(PG8_SB(1, 0), b3, voffB); PG8_STAGE(PG8_SB(1, 1), b3 + hsB, voffB); PG8_STAGE_A(PG8_SA(1, 0), a3, 0, g2);
            PG8_WAIT_V(8); PG8_WAIT_L(0); PG8_BAR; PG8_MMA(1, 0, At, B0); PG8_MMA(1, 1, At, B1); PG8_BAR; PG8_SCHED;
        }
        if (wr == 0) PG8_BAR;
        { int ln; asm volatile("v_mbcnt_lo_u32_b32 %0, -1, 0\n\tv_mbcnt_hi_u32_b32 %0, -1, %0" : "=v"(ln));
          E(acc, cur, wr, wc, ln & 15, ln >> 4); }
        if (!has_next) break;
        if (!E.keep(cur))
#pragma unroll
        for (int a = 0; a < 2; ++a)
#pragma unroll
            for (int b = 0; b < 2; ++b)
#pragma unroll
                for (int m = 0; m < 4; ++m)
#pragma unroll
                    for (int n = 0; n < 2; ++n) acc[a][b][m][n] = (f32x4){zr, zr, zr, zr};
        cur = nxt; cA = nA; cB = nB; ++ui;
        if constexpr (GATHER) { _Pragma("unroll") for (int h_ = 0; h_ < 2; ++h_) _Pragma("unroll") for (int i_ = 0; i_ < 2; ++i_) gC[h_][i_] = gN[h_][i_]; }

        if (wr == 1) PG8_BAR;
    }
    PG8_WAIT_V(0);
    PG8_BAR;
#undef PG8_SA
#undef PG8_SB
#undef PG8_STAGE
#undef PG8_STAGE_A
#undef PG8_GOFF
#undef PG8_LDA
#undef PG8_LDB
#undef PG8_MMA
#undef PG8_WAIT_V
#undef PG8_WAIT_L
#undef PG8_BAR
#undef PG8_SCHED
}
}

__device__ __forceinline__ float row16_sum(float v);
namespace att {
#define SBAR() __builtin_amdgcn_sched_barrier(0)
__device__ __forceinline__ int crow(int r, int hi) { return (r & 3) + 8 * (r >> 2) + 4 * hi; }
__device__ __forceinline__ unsigned cvtpk(float lo, float hi) { unsigned r; asm volatile("v_cvt_pk_bf16_f32 %0, %1, %2" : "=v"(r) : "v"(lo), "v"(hi)); return r; }
template <int DQK> __device__ __forceinline__ int kswz(int row, int colB) {
    if (DQK == 64) return row * 128 + (colB ^ (((row >> 1) & 7) << 4));
    else return row * 256 + (colB ^ ((row & 15) << 4));
}
template <int DQK> struct KCfg { static constexpr int KP = (DQK == 64) ? 128 : 256, SHM_K = 64 * KP, CPR = DQK / 8, NKC = (64 * CPR + 511) / 512, NQ = DQK / 16; };
template <int DV> struct VCfg { static constexpr int NCB = DV / 32, SHM_V = 64 * DV * 2, CPR = DV / 8, NVC = (64 * CPR) / 512; };
template <int NCB> __device__ __forceinline__ int v_st(int k, int c) { const int kk = (k & ~0xC) | ((k & 4) << 1) | ((k & 8) >> 1); return ((kk >> 3) * NCB + (c >> 5)) * 512 + ((kk & 7) * 32 + (c & 31)) * 2; }
__device__ __forceinline__ int v_rd_base(int lane) { return ((lane & 3) << 3) | (((lane >> 2) & 3) << 6) | (((lane >> 4) & 1) << 5) | (((lane >> 5) & 1) << 8); }
template <int OFF> __device__ __forceinline__ s16x4 tr_read(int vb) { s16x4 r; asm volatile("ds_read_b64_tr_b16 %0, %1 offset:%2" : "=&v"(r) : "v"(vb), "i"(OFF) : "memory"); return r; }

__device__ __forceinline__ void partialSM(f32x16& p0, f32x16& p1, float& m_reg, float& alpha, float C, float thr) {
    float pmax = p0[0];
#pragma unroll
    for (int r = 1; r < 16; ++r) pmax = fmaxf(pmax, p0[r]);
#pragma unroll
    for (int r = 0; r < 16; ++r) pmax = fmaxf(pmax, p1[r]);
    { auto rr = __builtin_amdgcn_permlane32_swap(__float_as_uint(pmax), __float_as_uint(pmax), false, false); pmax = fmaxf(__uint_as_float(rr[0]), __uint_as_float(rr[1])); }
    float mn;
    if (__builtin_expect(__all(pmax - m_reg <= thr), 1)) { mn = m_reg; alpha = 1.f; }
    else { mn = fmaxf(m_reg, pmax); alpha = __builtin_amdgcn_exp2f((m_reg - mn) * C); m_reg = mn; }
    const float mnC = -mn * C;
#pragma unroll
    for (int r = 0; r < 16; ++r) p0[r] = fmaf(p0[r], C, mnC);
#pragma unroll
    for (int r = 0; r < 16; ++r) p1[r] = fmaf(p1[r], C, mnC);
#pragma unroll
    for (int r = 0; r < 16; ++r) p0[r] = __builtin_amdgcn_exp2f(p0[r]);
}
__device__ __forceinline__ void finishSM(f32x16& p0, f32x16& p1, float alpha, float& l_reg, bf16x8& pa0, bf16x8& pa1, bf16x8& pa2, bf16x8& pa3) {
#pragma unroll
    for (int r = 0; r < 16; ++r) p1[r] = __builtin_amdgcn_exp2f(p1[r]);
    float ps = 0;
#pragma unroll
    for (int r = 0; r < 16; ++r) ps += p0[r];
#pragma unroll
    for (int r = 0; r < 16; ++r) ps += p1[r];
    { auto rr = __builtin_amdgcn_permlane32_swap(__float_as_uint(ps), __float_as_uint(ps), false, false); ps = __uint_as_float(rr[0]) + __uint_as_float(rr[1]); }
    l_reg = l_reg * alpha + ps;
#define PK4(P, BASE, OUT) do { unsigned a0 = cvtpk(P[BASE + 0], P[BASE + 1]), a1 = cvtpk(P[BASE + 2], P[BASE + 3]);   \
    unsigned b0 = cvtpk(P[BASE + 4], P[BASE + 5]), b1 = cvtpk(P[BASE + 6], P[BASE + 7]);                              \
    auto r0 = __builtin_amdgcn_permlane32_swap(a0, b0, false, false); auto r1 = __builtin_amdgcn_permlane32_swap(a1, b1, false, false); \
    u32x4 w = {r0[0], r1[0], r0[1], r1[1]}; OUT = __builtin_bit_cast(bf16x8, w); } while (0)
    PK4(p0, 0, pa0); PK4(p0, 8, pa1); PK4(p1, 0, pa2); PK4(p1, 8, pa3);
#undef PK4
}
__device__ __forceinline__ void finishSM_pack(f32x16& p0, f32x16& p1, bf16x8& pa0, bf16x8& pa1, bf16x8& pa2, bf16x8& pa3) {
#define PK4(P, BASE, OUT) do { unsigned a0 = cvtpk(P[BASE + 0], P[BASE + 1]), a1 = cvtpk(P[BASE + 2], P[BASE + 3]);   \
    unsigned b0 = cvtpk(P[BASE + 4], P[BASE + 5]), b1 = cvtpk(P[BASE + 6], P[BASE + 7]);                              \
    auto r0 = __builtin_amdgcn_permlane32_swap(a0, b0, false, false); auto r1 = __builtin_amdgcn_permlane32_swap(a1, b1, false, false); \
    u32x4 w = {r0[0], r1[0], r0[1], r1[1]}; OUT = __builtin_bit_cast(bf16x8, w); } while (0)
    PK4(p0, 0, pa0); PK4(p0, 8, pa1); PK4(p1, 0, pa2); PK4(p1, 8, pa3);
#undef PK4
}
template <int DQK> __device__ __forceinline__ void qkt(f32x16& p0, f32x16& p1, const LAS char* Ks, const bf16x8* qr, int r32, int hi) {
    p0 = f32x16{}; p1 = f32x16{};
#pragma unroll
    for (int d0 = 0; d0 < DQK / 16; ++d0) { const int cb = (d0 * 16 + hi * 8) * 2;
        const bf16x8 b0 = *(const LAS bf16x8*)(Ks + kswz<DQK>(r32, cb));
        const bf16x8 b1 = *(const LAS bf16x8*)(Ks + kswz<DQK>(32 + r32, cb));
        p0 = __builtin_amdgcn_mfma_f32_32x32x16_bf16(b0, qr[d0], p0, 0, 0, 0);
        p1 = __builtin_amdgcn_mfma_f32_32x32x16_bf16(b1, qr[d0], p1, 0, 0, 0); }
}
template <int NCB, int D0> __device__ __forceinline__ void pv_one(f32x16& od, int vb, bf16x8 pa0, bf16x8 pa1, bf16x8 pa2, bf16x8 pa3) {
#define VOFF(ks, half) (((2 * (ks) + (half)) * NCB + D0) * 512)
    s16x4 l0 = tr_read<VOFF(0, 0)>(vb), h0 = tr_read<VOFF(0, 1)>(vb), l1 = tr_read<VOFF(1, 0)>(vb), h1 = tr_read<VOFF(1, 1)>(vb);
    s16x4 l2 = tr_read<VOFF(2, 0)>(vb), h2 = tr_read<VOFF(2, 1)>(vb), l3 = tr_read<VOFF(3, 0)>(vb), h3 = tr_read<VOFF(3, 1)>(vb);
#undef VOFF
    asm volatile("s_waitcnt lgkmcnt(0)" : "+v"(l0), "+v"(h0), "+v"(l1), "+v"(h1), "+v"(l2), "+v"(h2), "+v"(l3), "+v"(h3) :: "memory");
#define PK(L, H) (bf16x8){L[0], L[1], L[2], L[3], H[0], H[1], H[2], H[3]}
    od = __builtin_amdgcn_mfma_f32_32x32x16_bf16(pa0, PK(l0, h0), od, 0, 0, 0);
    od = __builtin_amdgcn_mfma_f32_32x32x16_bf16(pa1, PK(l1, h1), od, 0, 0, 0);
    od = __builtin_amdgcn_mfma_f32_32x32x16_bf16(pa2, PK(l2, h2), od, 0, 0, 0);
    od = __builtin_amdgcn_mfma_f32_32x32x16_bf16(pa3, PK(l3, h3), od, 0, 0, 0);
#undef PK
}
template <int DV> __device__ __forceinline__ void pv_all(f32x16* o, int vb, bf16x8 pa0, bf16x8 pa1, bf16x8 pa2, bf16x8 pa3) {
    constexpr int NCB = DV / 32;
    pv_one<NCB, 0>(o[0], vb, pa0, pa1, pa2, pa3); pv_one<NCB, 1>(o[1], vb, pa0, pa1, pa2, pa3);
    if constexpr (NCB == 4) { pv_one<NCB, 2>(o[2], vb, pa0, pa1, pa2, pa3); pv_one<NCB, 3>(o[3], vb, pa0, pa1, pa2, pa3); }
}

__device__ __forceinline__ void dense_unit_dma(const bf16_t* __restrict__ Qb, int ldq, const bf16_t* __restrict__ K1, int ldk1, const bf16_t* __restrict__ Vh, int ldv,
                                               bf16_t* __restrict__ Ob, int ldo, int seq, float C, float thr, LAS char* lds, const int tid,
                                               int epi = 0, float lam = 0.f, const bf16_t* __restrict__ O1b = nullptr, int ldo1 = 0) {
    constexpr int DQK = 64, DV = 128, NQ = 4, NCB = 4, SLOT = 24576, VOFFB = 8192;
    const int wid = __builtin_amdgcn_readfirstlane(tid >> 6), lane = tid & 63, r32 = lane & 31, hi = lane >> 5;
    LAS float* al_l = (LAS float*)(lds + 3 * SLOT) + wid * 64;
    float mC = 0.f, l_reg = 0.f; f32x16 o[NCB], cinit = f32x16{}; bf16x8 qr[NQ]; const float thrC = thr * C;
    const bf16x8 ones = {0x3f80, 0x3f80, 0x3f80, 0x3f80, 0x3f80, 0x3f80, 0x3f80, 0x3f80};
#pragma unroll
    for (int i = 0; i < NCB; ++i) o[i] = f32x16{};
    { const bf16_t* Qw = Qb + (long)(wid * 32 + r32) * ldq + hi * 8;
#pragma unroll
      for (int d0 = 0; d0 < NQ; ++d0) { const u32x4 raw = *(const u32x4*)(Qw + d0 * 16); u32x4 sc;
#pragma unroll
          for (int i = 0; i < 4; ++i) sc[i] = cvtpk(__uint_as_float(raw[i] << 16) * C, __uint_as_float(raw[i] & 0xffff0000u) * C);
          qr[d0] = __builtin_bit_cast(bf16x8, sc); } }
    unsigned koff, voff0, voff1;
    { const int row = tid >> 3, ch = (tid & 7) ^ ((row >> 1) & 7); koff = (unsigned)(row * ldk1 + ch * 8) * 2u; }
    { const int p = tid, sub = p >> 5, w = p & 31, kk = (sub >> 2) * 8 + (w >> 2), k = (kk & ~0xC) | ((kk & 4) << 1) | ((kk & 8) >> 1), c = (sub & 3) * 32 + (w & 3) * 8; voff0 = (unsigned)(k * ldv + c) * 2u; }
    { const int p = 512 + tid, sub = p >> 5, w = p & 31, kk = (sub >> 2) * 8 + (w >> 2), k = (kk & ~0xC) | ((kk & 4) << 1) | ((kk & 8) >> 1), c = (sub & 3) * 32 + (w & 3) * 8; voff1 = (unsigned)(k * ldv + c) * 2u; }
    const size_t kts = (size_t)64 * ldk1 * 2, vts = (size_t)64 * ldv * 2;
    const int vb0 = (int)(unsigned)(unsigned long)lds + VOFFB + v_rd_base(lane);
    const int NT = seq / 64;
#define DMA(t, so) do { if ((t) < NT) { \
        __builtin_amdgcn_global_load_lds((const unsigned*)((const char*)K1 + (size_t)(t) * kts + koff), (LAS unsigned*)(lds + (so) + wid * 1024), 16, 0, 0); \
        __builtin_amdgcn_global_load_lds((const unsigned*)((const char*)Vh + (size_t)(t) * vts + voff0), (LAS unsigned*)(lds + (so) + VOFFB + wid * 1024), 16, 0, 0); \
        __builtin_amdgcn_global_load_lds((const unsigned*)((const char*)Vh + (size_t)(t) * vts + voff1), (LAS unsigned*)(lds + (so) + VOFFB + 8192 + wid * 1024), 16, 0, 0); } } while (0)
#define TBAR() do { asm volatile("s_waitcnt vmcnt(0)" ::: "memory"); __builtin_amdgcn_s_barrier(); asm volatile("" ::: "memory"); } while (0)
#define LSUM() do { ls = __builtin_amdgcn_mfma_f32_32x32x16_bf16(pa0, ones, ls, 0, 0, 0); ls = __builtin_amdgcn_mfma_f32_32x32x16_bf16(pa1, ones, ls, 0, 0, 0); ls = __builtin_amdgcn_mfma_f32_32x32x16_bf16(pa2, ones, ls, 0, 0, 0); ls = __builtin_amdgcn_mfma_f32_32x32x16_bf16(pa3, ones, ls, 0, 0, 0); } while (0)
    f32x16 pA0, pA1, pB0, pB1; bf16x8 pa0, pa1, pa2, pa3;
#define FINS(P0, P1) do { _Pragma("unroll") for (int r = 0; r < 16; ++r) P1[r] = __builtin_amdgcn_exp2f(P1[r]); \
        f32x2 s2_ = {P0[0], P0[1]}; _Pragma("unroll") for (int k = 1; k < 8; ++k) s2_ += (f32x2){P0[2 * k], P0[2 * k + 1]}; _Pragma("unroll") for (int k = 0; k < 8; ++k) s2_ += (f32x2){P1[2 * k], P1[2 * k + 1]}; \
        l_reg += s2_[0] + s2_[1]; finishSM_pack(P0, P1, pa0, pa1, pa2, pa3); } while (0)
#define QKC(P0, P1, so) do { _Pragma("unroll") for (int d0 = 0; d0 < NQ; ++d0) { const int cb = (d0 * 16 + hi * 8) * 2; \
        const bf16x8 b0 = *(const LAS bf16x8*)(lds + (so) + kswz<DQK>(r32, cb)), b1 = *(const LAS bf16x8*)(lds + (so) + kswz<DQK>(32 + r32, cb)); \
        if (d0 == 0) { P0 = __builtin_amdgcn_mfma_f32_32x32x16_bf16(b0, qr[0], cinit, 0, 0, 0); P1 = __builtin_amdgcn_mfma_f32_32x32x16_bf16(b1, qr[0], cinit, 0, 0, 0); } \
        else { P0 = __builtin_amdgcn_mfma_f32_32x32x16_bf16(b0, qr[d0], P0, 0, 0, 0); P1 = __builtin_amdgcn_mfma_f32_32x32x16_bf16(b1, qr[d0], P1, 0, 0, 0); } } } while (0)
#define SMAX(P0, P1, FORCE) do { float pmax = P0[0]; \
        _Pragma("unroll") for (int r = 1; r < 16; ++r) pmax = fmaxf(pmax, P0[r]); \
        _Pragma("unroll") for (int r = 0; r < 16; ++r) pmax = fmaxf(pmax, P1[r]); \
        { auto rr = __builtin_amdgcn_permlane32_swap(__float_as_uint(pmax), __float_as_uint(pmax), false, false); pmax = fmaxf(__uint_as_float(rr[0]), __uint_as_float(rr[1])); } \
        if (FORCE || !__all(pmax <= thrC)) { const float dl = FORCE ? pmax : fmaxf(pmax, 0.f); mC += dl; \
            _Pragma("unroll") for (int r = 0; r < 16; ++r) { cinit[r] = -mC; P0[r] -= dl; P1[r] -= dl; } \
            if (!FORCE) { if (hi == 0) al_l[r32] = __builtin_amdgcn_exp2f(-dl); asm volatile("s_waitcnt lgkmcnt(0)" ::: "memory"); \
                _Pragma("unroll") for (int d = 0; d < NCB; ++d) _Pragma("unroll") for (int r = 0; r < 16; ++r) o[d][r] *= al_l[crow(r, hi)]; \
                l_reg *= __builtin_amdgcn_exp2f(-dl); } } } while (0)
#define EXP0(P0) do { _Pragma("unroll") for (int r = 0; r < 16; ++r) P0[r] = __builtin_amdgcn_exp2f(P0[r]); } while (0)
    int s0 = 0, s1 = SLOT, s2 = 2 * SLOT;
    DMA(0, s0); DMA(1, s1); TBAR();
    QKC(pA0, pA1, s0); SMAX(pA0, pA1, true); EXP0(pA0);
    DMA(2, s2);
    for (int j = 0; j + 2 < NT; j += 2) {
        QKC(pB0, pB1, s1);
        FINS(pA0, pA1);
        pv_all<DV>(o, vb0 + s0, pa0, pa1, pa2, pa3);  SMAX(pB0, pB1, false);
        TBAR(); DMA(j + 3, s0); EXP0(pB0);
        QKC(pA0, pA1, s2);
        FINS(pB0, pB1);
        pv_all<DV>(o, vb0 + s1, pa0, pa1, pa2, pa3);  SMAX(pA0, pA1, false);
        TBAR(); DMA(j + 4, s1); EXP0(pA0);
        { const int t = s0; s0 = s2; s2 = s1; s1 = t; }
    }
    QKC(pB0, pB1, s1);
    FINS(pA0, pA1);
    pv_all<DV>(o, vb0 + s0, pa0, pa1, pa2, pa3);  SMAX(pB0, pB1, false); EXP0(pB0);
    FINS(pB0, pB1);
    pv_all<DV>(o, vb0 + s1, pa0, pa1, pa2, pa3);
#undef QKC
#undef SMAX
#undef EXP0
    { auto rr = __builtin_amdgcn_permlane32_swap(__float_as_uint(l_reg), __float_as_uint(l_reg), false, false); l_reg = __uint_as_float(rr[0]) + __uint_as_float(rr[1]); }
    if (hi == 0) al_l[r32] = l_reg; asm volatile("s_waitcnt lgkmcnt(0)" ::: "memory");
    float rli[16];
#pragma unroll
    for (int r = 0; r < 16; ++r) rli[r] = __builtin_amdgcn_rcpf(al_l[crow(r, hi)]);
    asm volatile("s_waitcnt lgkmcnt(0)" ::: "memory");
    __syncthreads();
    { LAS bf16_t* stg = (LAS bf16_t*)(lds + wid * (32 * DV * 2));
      constexpr int CPR = DV / 8;
      if (epi == 0) {
#pragma unroll
          for (int r = 0; r < 16; ++r) { const int orow = crow(r, hi);
#pragma unroll
              for (int d0 = 0; d0 < NCB; ++d0) stg[orow * DV + d0 * 32 + r32] = (bf16_t)(cvtpk(o[d0][r] * rli[r], 0.f) & 0xffffu); }
      } else {
          LAS bf16_t* st1 = (LAS bf16_t*)(lds + 65536 + wid * (32 * DV * 2));
          const bf16_t* O1w = O1b + (long)(wid * 32) * ldo1;
#pragma unroll
          for (int i = 0; i < 32 * CPR / 64; ++i) { const int id = i * 64 + lane, row = id / CPR, ch = id % CPR; *(LAS u32x4*)(st1 + row * DV + ch * 8) = *(const u32x4*)(O1w + (long)row * ldo1 + ch * 8); }
          asm volatile("s_waitcnt lgkmcnt(0)" ::: "memory");
          float ss[16];
#pragma unroll
          for (int r = 0; r < 16; ++r) { const int orow = crow(r, hi); float s = 0.f;
#pragma unroll
              for (int d0 = 0; d0 < NCB; ++d0) { const float o1 = __uint_as_float((unsigned)st1[orow * DV + d0 * 32 + r32] << 16);
                  const float o2 = __uint_as_float(cvtpk(0.f, o[d0][r] * rli[r]) & 0xffff0000u);
                  const float dv = o1 - lam * o2; o[d0][r] = dv; s += dv * dv; }
              ss[r] = s; }
#pragma unroll
          for (int r = 0; r < 16; ++r) { float s = row16_sum(ss[r]);
              { auto rr = __builtin_amdgcn_permlane16_swap(__float_as_uint(s), __float_as_uint(s), false, false); s = __uint_as_float(rr[0]) + __uint_as_float(rr[1]); }
              ss[r] = 1.0f / sqrtf(s * (1.f / 128.f) + RMS_EPS); }
#pragma unroll
          for (int r = 0; r < 16; ++r) { const int orow = crow(r, hi);
#pragma unroll
              for (int d0 = 0; d0 < NCB; ++d0) stg[orow * DV + d0 * 32 + r32] = (bf16_t)(cvtpk(o[d0][r] * ss[r], 0.f) & 0xffffu); }
      }
      asm volatile("s_waitcnt lgkmcnt(0)" ::: "memory");
      bf16_t* Ow = Ob + (long)(wid * 32) * ldo;
#pragma unroll
      for (int i = 0; i < 32 * CPR / 64; ++i) { const int id = i * 64 + lane, row = id / CPR, ch = id % CPR;
          st128(Ow + (long)row * ldo + ch * 8, *(const LAS u32x4*)(stg + row * DV + ch * 8)); }
      if (epi == 0) asm volatile("s_waitcnt vmcnt(0)" ::: "memory");
    }
    __syncthreads();
#undef DMA
#undef TBAR
#undef LSUM
#undef FINS
}


__device__ __forceinline__ void dense_unit64_hp(const bf16_t* __restrict__ Qb, int ldq, const bf16_t* __restrict__ K1, int ldk1, const bf16_t* __restrict__ K2, int ldk2,
                                                 const bf16_t* __restrict__ Vh, int ldv, bf16_t* __restrict__ Ob, int ldo, int seq, float C, float thr, LAS char* lds, const int tid) {
    constexpr int DQK = 96, DV = 64, NQ = 6, NQR = 6, NCB = 2, SLOT = 24576, VOFFB = 16384;
    const int wid = __builtin_amdgcn_readfirstlane(tid >> 6), lane = tid & 63, r32 = lane & 31, hi = lane >> 5;
    LAS float* wsf = (LAS float*)(lds + 3 * SLOT) + wid * 128;
    float mCA = 0.f, mCB = 0.f, lA = 0.f, lB = 0.f; f32x16 oA[2], oB[2]; bf16x8 qa[NQR]; unsigned qeA = 0u, qeB = 0u;
    LAS char* qparkA = nullptr;
    LAS char* qpark = lds + 3 * SLOT + 4096 + wid * (NQ * 1024) + lane * 16;
    const float thrC = thr * C;
    const bf16x8 ones = {0x3f80, 0x3f80, 0x3f80, 0x3f80, 0x3f80, 0x3f80, 0x3f80, 0x3f80};
    oA[0] = f32x16{}; oA[1] = f32x16{}; oB[0] = f32x16{}; oB[1] = f32x16{};
    { const bf16_t* Qw = Qb + (long)(wid * 64 + r32) * ldq + hi * 8;
#pragma unroll
      for (int d0 = 0; d0 < NQ; ++d0) { const u32x4 ra = *(const u32x4*)(Qw + d0 * 16), rb = *(const u32x4*)(Qw + 32L * ldq + d0 * 16); u32x4 sa, sb;
#pragma unroll
          for (int i = 0; i < 4; ++i) { sa[i] = cvtpk(__uint_as_float(ra[i] << 16) * C, __uint_as_float(ra[i] & 0xffff0000u) * C); sb[i] = cvtpk(__uint_as_float(rb[i] << 16) * C, __uint_as_float(rb[i] & 0xffff0000u) * C); }
          if (d0 < NQR) qa[d0] = __builtin_bit_cast(bf16x8, sa); else *(LAS u32x4*)(qparkA + (d0 - NQR) * 1024) = sa; *(LAS u32x4*)(qpark + d0 * 1024) = sb; } }
    const char* kbase = (const char*)K1 < (const char*)K2 ? (const char*)K1 : (const char*)K2;
    unsigned koff0, kst, voff;
    { const int row = tid >> 4, ch = (tid & 15) ^ (row & 15);
      if (ch >= 8 && ch < 12) { koff0 = (unsigned)((const char*)K2 - kbase) + (unsigned)(row * ldk2 + (ch - 8) * 8) * 2u; kst = (unsigned)(64 * ldk2) * 2u; }
      else { koff0 = (unsigned)((const char*)K1 - kbase) + (unsigned)(row * ldk1 + (ch & 7) * 8) * 2u; kst = (unsigned)(64 * ldk1) * 2u; } }
    { const int p = tid, sub = p >> 5, w = p & 31, kk = (sub >> 1) * 8 + (w >> 2), k = (kk & ~0xC) | ((kk & 4) << 1) | ((kk & 8) >> 1), c = (sub & 1) * 32 + (w & 3) * 8; voff = (unsigned)(k * ldv + c) * 2u; }
    const size_t vts = (size_t)64 * ldv * 2;
    const int vb0 = (int)(unsigned)(unsigned long)lds + VOFFB + v_rd_base(lane);
    const int NT = seq / 64;
#define DMA(t, so) do { if ((t) < NT) { \
        __builtin_amdgcn_global_load_lds((const unsigned*)(kbase + koff0), (LAS unsigned*)(lds + (so) + wid * 1024), 16, 0, 0); \
        __builtin_amdgcn_global_load_lds((const unsigned*)(kbase + (koff0 + (kst >> 1))), (LAS unsigned*)(lds + (so) + 8192 + wid * 1024), 16, 0, 0); \
        __builtin_amdgcn_global_load_lds((const unsigned*)((const char*)Vh + (size_t)(t) * vts + voff), (LAS unsigned*)(lds + (so) + VOFFB + wid * 1024), 16, 0, 0); \
        koff0 += kst; } } while (0)
#define TBAR() do { asm volatile("s_waitcnt vmcnt(0)" ::: "memory"); __builtin_amdgcn_s_barrier(); asm volatile("" ::: "memory"); } while (0)
    int s0 = 0, s1 = SLOT, s2 = 2 * SLOT;
    f32x16 a0, a1, b0, b1, cA = f32x16{}, cB = f32x16{};
#define QKH(P0, P1, CI, QF, so) do { const LAS char* Ks = lds + (so); \
        _Pragma("unroll") for (int d0 = 0; d0 < NQ; ++d0) { const int cb = (d0 * 16 + hi * 8) * 2; \
            const bf16x8 k0 = *(const LAS bf16x8*)(Ks + kswz<DQK>(r32, cb)), k1 = *(const LAS bf16x8*)(Ks + kswz<DQK>(32 + r32, cb)); const bf16x8 qf_ = QF(d0); \
            if (d0 == 0) { P0 = __builtin_amdgcn_mfma_f32_32x32x16_bf16(k0, qf_, CI, 0, 0, 0); P1 = __builtin_amdgcn_mfma_f32_32x32x16_bf16(k1, qf_, CI, 0, 0, 0); } \
            else { P0 = __builtin_amdgcn_mfma_f32_32x32x16_bf16(k0, qf_, P0, 0, 0, 0); P1 = __builtin_amdgcn_mfma_f32_32x32x16_bf16(k1, qf_, P1, 0, 0, 0); } } } while (0)
#define QFA(d0) qa[d0]
#define QFB(d0) (*(const LAS bf16x8*)(qpark + (d0) * 1024))
#define EXPSUM(P0, P1, PS) do { _Pragma("unroll") for (int r = 0; r < 16; ++r) { P0[r] = __builtin_amdgcn_exp2f(P0[r]); P1[r] = __builtin_amdgcn_exp2f(P1[r]); } \
        f32x2 s2_ = {P0[0], P0[1]}; _Pragma("unroll") for (int k = 1; k < 8; ++k) s2_ += (f32x2){P0[2 * k], P0[2 * k + 1]}; _Pragma("unroll") for (int k = 0; k < 8; ++k) s2_ += (f32x2){P1[2 * k], P1[2 * k + 1]}; \
        PS = s2_[0] + s2_[1]; } while (0)
#define RARE(P0, P1, PS, MC, CI, QF, L, O, WOFF, so) do { asm volatile("" ::: "memory"); QKH(P0, P1, CI, QF, so); \
        float pm_ = P0[0]; _Pragma("unroll") for (int r = 1; r < 16; ++r) pm_ = fmaxf(pm_, P0[r]); _Pragma("unroll") for (int r = 0; r < 16; ++r) pm_ = fmaxf(pm_, P1[r]); \
        { auto rr = __builtin_amdgcn_permlane32_swap(__float_as_uint(pm_), __float_as_uint(pm_), false, false); pm_ = fmaxf(__uint_as_float(rr[0]), __uint_as_float(rr[1])); } \
        const float d_ = (j == 0 ? pm_ : fmaxf(pm_, 0.f)); MC += d_; \
        int lr; asm volatile("v_mbcnt_lo_u32_b32 %0, -1, 0\n\tv_mbcnt_hi_u32_b32 %0, -1, %0" : "=v"(lr)); const int r32r = lr & 31, hir = lr >> 5; \
        _Pragma("unroll") for (int r = 0; r < 16; ++r) { CI[r] = -MC; P0[r] -= d_; P1[r] -= d_; } \
        const float al_ = __builtin_amdgcn_exp2f(-d_); L *= al_; \
        if (hir == 0) wsf[WOFF + r32r] = al_; asm volatile("s_waitcnt lgkmcnt(0)" ::: "memory"); \
        _Pragma("unroll") for (int d = 0; d < 2; ++d) _Pragma("unroll") for (int r = 0; r < 16; ++r) O[d][r] *= wsf[WOFF + crow(r, hir)]; \
        EXPSUM(P0, P1, PS); } while (0)
#define PVH(O, Q0, Q1, Q2, Q3, so) do { const int vb = vb0 + (so); pv_one<NCB, 0>(O[0], vb, Q0, Q1, Q2, Q3); pv_one<NCB, 1>(O[1], vb, Q0, Q1, Q2, Q3); } while (0)
    DMA(0, s0); DMA(1, s1); TBAR();
    QKH(a0, a1, cA, QFA, s0);
    for (int j = 0; j < NT; ++j) {
        DMA(j + 2, s2);
        bf16x8 pa0, pa1, pa2, pa3, pb0, pb1, pb2, pb3; float psA, psB;
        const float lim = j == 0 ? -1.f : 65536.f;
        QKH(b0, b1, cB, QFB, s0);
        EXPSUM(a0, a1, psA);
        if (__any(!(psA <= lim))) RARE(a0, a1, psA, mCA, cA, QFA, lA, oA, 64, s0);
        lA += psA; finishSM_pack(a0, a1, pa0, pa1, pa2, pa3);
        QKH(a0, a1, cA, QFA, s1);
        PVH(oA, pa0, pa1, pa2, pa3, s0);
        EXPSUM(b0, b1, psB);
        if (__any(!(psB <= lim))) RARE(b0, b1, psB, mCB, cB, QFB, lB, oB, 96, s0);
        lB += psB; finishSM_pack(b0, b1, pb0, pb1, pb2, pb3);
        PVH(oB, pb0, pb1, pb2, pb3, s0);
        TBAR();
        { const int t = s0; s0 = s1; s1 = s2; s2 = t; }
    }
    int lanee; asm volatile("v_mbcnt_lo_u32_b32 %0, -1, 0\n\tv_mbcnt_hi_u32_b32 %0, -1, %0" : "=v"(lanee)); const int r32e = lanee & 31, hie = lanee >> 5;
    { auto rr = __builtin_amdgcn_permlane32_swap(__float_as_uint(lA), __float_as_uint(lA), false, false); lA = __uint_as_float(rr[0]) + __uint_as_float(rr[1]); }
    { auto rr = __builtin_amdgcn_permlane32_swap(__float_as_uint(lB), __float_as_uint(lB), false, false); lB = __uint_as_float(rr[0]) + __uint_as_float(rr[1]); }
    if (hie == 0) { wsf[r32e] = lA; wsf[32 + r32e] = lB; } asm volatile("s_waitcnt lgkmcnt(0)" ::: "memory");
    float rlA[16], rlB[16];
#pragma unroll
    for (int r = 0; r < 16; ++r) { rlA[r] = __builtin_amdgcn_rcpf(wsf[crow(r, hie)]); rlB[r] = __builtin_amdgcn_rcpf(wsf[32 + crow(r, hie)]); }
    asm volatile("s_waitcnt lgkmcnt(0)" ::: "memory");
    __syncthreads();
    { LAS bf16_t* stg = (LAS bf16_t*)(lds + wid * (64 * DV * 2));
#pragma unroll
      for (int r = 0; r < 16; ++r) { const int orow = crow(r, hie);
#pragma unroll
          for (int d0 = 0; d0 < NCB; ++d0) { stg[orow * DV + d0 * 32 + r32e] = (bf16_t)(cvtpk(oA[d0][r] * rlA[r], 0.f) & 0xffffu); stg[(32 + orow) * DV + d0 * 32 + r32e] = (bf16_t)(cvtpk(oB[d0][r] * rlB[r], 0.f) & 0xffffu); } }
      asm volatile("s_waitcnt lgkmcnt(0)" ::: "memory");
      bf16_t* Ow = Ob + (long)(wid * 64) * ldo; constexpr int CPR = DV / 8;
#pragma unroll
      for (int i = 0; i < 64 * CPR / 64; ++i) { const int id = i * 64 + lanee, row = id / CPR, ch = id % CPR;
          st128(Ow + (long)row * ldo + ch * 8, *(const LAS u32x4*)(stg + row * DV + ch * 8)); } }
    __syncthreads();
#undef DMA
#undef TBAR
#undef QKH
#undef EXPSUM
#undef RARE
#undef PVH
}


__device__ __forceinline__ void band_unit(const bf16_t* __restrict__ Qh, int ldq, const bf16_t* __restrict__ Kh, int ldk, const bf16_t* __restrict__ Vh, int ldv,
                                          bf16_t* __restrict__ Oh, int ldo, float* __restrict__ lse, int ldl, int dil, int L, int j0, float C, float scale, LAS char* lds, const int tid) {
    constexpr int DQK = 64, DV = 128, NCB = 4, NQ = 4;
    const int wid = __builtin_amdgcn_readfirstlane(tid >> 6), lane = tid & 63, r32 = lane & 31, hi = lane >> 5;
    LAS char* V_lds = lds; LAS char* K_lds = lds + 16384;
    LAS float* wsf = (LAS float*)(lds + 16384 + 8192) + wid * 64; LAS float* li_l = wsf; LAS float* al_l = wsf + 32;
    float m_reg = -1e30f, l_reg = 0.f; f32x16 o[NCB]; bf16x8 qr[NQ];
#pragma unroll
    for (int i = 0; i < NCB; ++i) o[i] = f32x16{};
    const int jq = j0 + wid * 32 + r32;
    const int wlo = jq - 64 < 0 ? 0 : jq - 64, whi = jq + 64 > L - 1 ? L - 1 : jq + 64;
    { const bf16_t* Qw = Qh + (long)jq * dil * ldq + hi * 8;
#pragma unroll
      for (int d0 = 0; d0 < NQ; ++d0) qr[d0] = *(const bf16x8*)(Qw + d0 * 16); }
    const int krow = tid >> 3, kch = tid & 7, kdst = kswz<64>(krow, kch * 16);
    const int vb0 = (int)(unsigned)(unsigned long)V_lds + v_rd_base(lane);
    const int mlo = wid >> 1;
    bf16x8 kv, vv[2];
#define BLOAD(k) do { int jk = j0 - 64 + 64 * (k) + krow; jk = jk < 0 ? 0 : (jk >= L ? L - 1 : jk); kv = *(const bf16x8*)(Kh + (long)jk * dil * ldk + kch * 8); \
        _Pragma("unroll") for (int i = 0; i < 2; ++i) { const int id = tid + 512 * i, row = id >> 4, c = (id & 15) * 8; int jv = j0 - 64 + 64 * (k) + row; jv = jv < 0 ? 0 : (jv >= L ? L - 1 : jv); \
            vv[i] = *(const bf16x8*)(Vh + (long)jv * dil * ldv + c); } } while (0)
    BLOAD(0);
    for (int k = 0; k < 6; ++k) {
        { *(LAS bf16x8*)(K_lds + kdst) = kv;
#pragma unroll
          for (int i = 0; i < 2; ++i) { const int id = tid + 512 * i, row = id >> 4, c = (id & 15) * 8; *(LAS bf16x8*)(V_lds + v_st<NCB>(row, c)) = vv[i]; } }
        if (k + 1 < 6) BLOAD(k + 1);
        __syncthreads();
        if (k >= mlo && k <= mlo + 2) {
            f32x16 p0, p1; qkt<64>(p0, p1, K_lds, qr, r32, hi);
            const int jb = j0 - 64 + 64 * k;
            if (!__all(jb >= wlo && jb + 63 <= whi)) { const int db = jb - wlo + 4 * hi; const unsigned span = (unsigned)(whi - wlo);
#pragma unroll
                for (int r = 0; r < 16; ++r) { const unsigned d1 = (unsigned)(db + (r & 3) + 8 * (r >> 2));
                    p0[r] = d1 <= span ? p0[r] : -INFINITY; p1[r] = d1 + 32u <= span ? p1[r] : -INFINITY; } }
            float alpha; partialSM(p0, p1, m_reg, alpha, C, 0.f);
            if (k > mlo && __any(alpha < 1.f)) { if (hi == 0) al_l[r32] = alpha; asm volatile("s_waitcnt lgkmcnt(0)" ::: "memory");
#pragma unroll
                for (int d = 0; d < NCB; ++d)
#pragma unroll
                    for (int r = 0; r < 16; ++r) o[d][r] *= al_l[crow(r, hi)]; }
            bf16x8 pa0, pa1, pa2, pa3; finishSM(p0, p1, alpha, l_reg, pa0, pa1, pa2, pa3); SBAR();
            pv_all<DV>(o, vb0, pa0, pa1, pa2, pa3);
        }
        __syncthreads();
    }
    if (hi == 0) { li_l[r32] = l_reg; st32f(lse + (long)jq * dil * ldl, m_reg * scale + __logf(l_reg)); }
    asm volatile("s_waitcnt lgkmcnt(0)" ::: "memory");
    { LAS bf16_t* stg = (LAS bf16_t*)(lds + 32768 + wid * 8192);
#pragma unroll
      for (int r = 0; r < 16; ++r) { const int orow = crow(r, hi); const float rl = __builtin_amdgcn_rcpf(li_l[orow]);
#pragma unroll
          for (int d0 = 0; d0 < NCB; ++d0) stg[orow * DV + d0 * 32 + r32] = (bf16_t)(cvtpk(o[d0][r] * rl, 0.f) & 0xffffu); }
      asm volatile("s_waitcnt lgkmcnt(0)" ::: "memory");
#pragma unroll
      for (int i = 0; i < 8; ++i) { const int id = i * 64 + lane, row = id >> 4, ch = id & 15; const long tok = (long)(j0 + wid * 32 + row) * dil;
          st128(Oh + tok * ldo + ch * 8, *(const LAS u32x4*)(stg + row * DV + ch * 8)); } }
    __syncthreads();
}
#undef BLOAD
#undef RESC
#undef SBAR
}

constexpr size_t MiB = 1u << 20;
constexpr size_t WS_CTL = 0, CTL_ZERO_BYTES = 1 * MiB;
constexpr size_t WB_IN = 0, WB_QB = WB_IN + (size_t)NIN_T * 1024 * 2, WB_KVB = WB_QB + (size_t)768 * 384 * 2, WB_BR = WB_KVB + (size_t)1024 * 256 * 2,
                 WB_OUT = WB_BR + (size_t)3 * 1024 * 512 * 2, WB_W1 = WB_OUT + (size_t)1024 * 1024 * 2, WB_W2 = WB_W1 + (size_t)17 * 512 * 1024 * 2,
                 WB_LAYER = WB_W2 + (size_t)17 * 1024 * 256 * 2;
constexpr size_t WS_W = 1 * MiB;
constexpr size_t WS_CH = ((WS_W + DEPTH * WB_LAYER + 255) / 256) * 256;
constexpr size_t TCB = (size_t)TC;
constexpr size_t R_XB = WS_CH;
constexpr size_t R_RP = R_XB + TCB * 2048;
constexpr size_t R_A = R_RP + TCB * 192;
constexpr size_t R_B = R_A + TCB * 3072;
constexpr size_t R_C = R_B + TCB * 1536;
constexpr size_t R_O = R_C + TCB * 6144;
constexpr size_t R_M = R_O + TCB * 5248;
constexpr size_t R_T = R_M + TCB * 3584;
constexpr int BASE_SH = 2 * TC + 4096;
constexpr int NROWS = 3 * TC + 4096;
constexpr size_t R_S = ((R_T + TCB * 24 + (size_t)NROWS * 8 + 255) / 256) * 256;
constexpr size_t WS_END = R_S + TCB * 3072;
static_assert((size_t)NROWS * 2048 <= TCB * (5248 + 3584), "XG fits R_O + R_M");
static_assert((size_t)NROWS * 512 <= TCB * 3072, "HID fits R_A");
constexpr int CW_BAR = 4096;
constexpr int CW_CNT = 16384;
constexpr int RING_BYTES = 131072, MISC_OFF = RING_BYTES, LDS_BYTES = 147456;

#define XB_TMO      128
#define XB_XCNT(j)  (256  + 64 * (j))
#define XB_XSUB(j)  (1280 + 64 * (j))
#define XB_XGEN(j)  (2304 + 64 * (j))
#define XB_TOP      3328
#define XB_TOPGEN   3392
#define XCD_BAR_WORDS 3456
#define XB_SPIN_CAP (1u << 22)
__device__ __forceinline__ unsigned xb_ld(unsigned* p)              { return __hip_atomic_load(p, __ATOMIC_RELAXED, __HIP_MEMORY_SCOPE_AGENT); }
__device__ __forceinline__ unsigned xb_add(unsigned* p, unsigned v) { return __hip_atomic_fetch_add(p, v, __ATOMIC_RELAXED, __HIP_MEMORY_SCOPE_AGENT); }
__device__ __forceinline__ unsigned xb_xcc_id() { return (unsigned)__builtin_amdgcn_s_getreg((3 << 11) | 20) & 0xFu; }
#define XB_SPIN(cond, bar) do { unsigned _sp = 0; while (cond) { __builtin_amdgcn_s_sleep(1); \
    if ((++_sp & 255u) == 0u) { if (xb_ld(&(bar)[XB_TMO])) break; if (_sp > XB_SPIN_CAP) { atomicAdd(&(bar)[XB_TMO], 1u); break; } } } } while (0)
struct XcdBarrier { unsigned* bar; unsigned x; volatile LAS unsigned* st; };
__device__ __forceinline__ XcdBarrier xcd_barrier_post(unsigned* bar, volatile LAS unsigned* st) {
    XcdBarrier b; b.bar = bar; b.x = xb_xcc_id(); b.st = st;
    if (threadIdx.x == 0) (void)xb_add(&bar[XB_XCNT(b.x)], 1u);
    return b;
}
__device__ __forceinline__ void xcd_barrier_complete(unsigned* bar, unsigned x, unsigned& nloc, unsigned& nx) {
    const unsigned G = gridDim.x * gridDim.y * gridDim.z;
    unsigned sum, cnt, mine, sp = 0u;
    for (;;) {
        sum = 0u; cnt = 0u; mine = 0u;
#pragma unroll
        for (unsigned j = 0; j < 16; ++j) { const unsigned c = xb_ld(&bar[XB_XCNT(j)]); sum += c; cnt += (c > 0u) ? 1u : 0u; mine = (j == x) ? c : mine; }
        if (sum == G) break;
        __builtin_amdgcn_s_sleep(1);
        if ((++sp & 255u) == 0u) { if (xb_ld(&bar[XB_TMO])) break; if (sp > XB_SPIN_CAP) { atomicAdd(&bar[XB_TMO], 1u); break; } }
    }
    nloc = mine > 0u ? mine : 1u; nx = cnt > 0u ? cnt : 1u;
}
__device__ __forceinline__ void xcd_barrier(const XcdBarrier& b) {
    asm volatile("s_waitcnt vmcnt(0)" ::: "memory");
    __syncthreads();
    if (threadIdx.x == 0) {
        unsigned* bar = b.bar;
        __builtin_amdgcn_s_waitcnt(0);
        unsigned nloc = b.st[0], nx = b.st[1];
        if (nloc == 0u) { xcd_barrier_complete(bar, b.x, nloc, nx); b.st[0] = nloc; b.st[1] = nx; }
        const unsigned old = xb_add(&bar[XB_XSUB(b.x)], 1u);
        const unsigned gen = old / nloc;
        if (old + 1u == (gen + 1u) * nloc) {
            __builtin_amdgcn_fence(__ATOMIC_RELEASE, "agent");
            asm volatile("s_waitcnt vmcnt(0)" ::: "memory");
            const unsigned og = xb_add(&bar[XB_TOP], 1u);
            const unsigned tg = og / nx;
            if (og + 1u == (tg + 1u) * nx) xb_add(&bar[XB_TOPGEN], 1u);
            else XB_SPIN(xb_ld(&bar[XB_TOPGEN]) == tg, bar);
            __builtin_amdgcn_fence(__ATOMIC_ACQUIRE, "agent");
            xb_add(&bar[XB_XGEN(b.x)], 1u);
            asm volatile("s_waitcnt vmcnt(0)" ::: "memory");
        } else {
            XB_SPIN(xb_ld(&bar[XB_XGEN(b.x)]) == gen, bar);
            __builtin_amdgcn_fence(__ATOMIC_ACQUIRE, "agent");
            asm volatile("s_waitcnt vmcnt(0)" ::: "memory");
        }
    }
    __syncthreads();
}

template <int CTRL> __device__ __forceinline__ float dppf(float v) { return __int_as_float(__builtin_amdgcn_update_dpp(0, __float_as_int(v), CTRL, 0xF, 0xF, true)); }
__device__ __forceinline__ float row16_sum(float v) { v += dppf<0xB1>(v); v += dppf<0x4E>(v); v += dppf<0x141>(v); v += dppf<0x140>(v); return v; }
__device__ __forceinline__ float wave_sum(float v) {
    v = row16_sum(v);
    { auto rr = __builtin_amdgcn_permlane16_swap(__float_as_uint(v), __float_as_uint(v), false, false); v = __uint_as_float(rr[0]) + __uint_as_float(rr[1]); }
    { auto rr = __builtin_amdgcn_permlane32_swap(__float_as_uint(v), __float_as_uint(v), false, false); v = __uint_as_float(rr[0]) + __uint_as_float(rr[1]); }
    return v;
}
__device__ __forceinline__ unsigned pk2(float lo, float hi) { return pg8::cvt_pk_bf16(lo, hi); }
__device__ __forceinline__ float bf2f(unsigned short h) { return __uint_as_float((unsigned)h << 16); }
__device__ __forceinline__ u32x4 pack8(const f32x4 a, const f32x4 b) { u32x4 w; w.x = pk2(a[0], a[1]); w.y = pk2(a[2], a[3]); w.z = pk2(b[0], b[1]); w.w = pk2(b[2], b[3]); return w; }
__device__ __forceinline__ void unpack8(const u32x4 w, f32x4& a, f32x4& b) {
    a[0] = __uint_as_float(w.x << 16); a[1] = __uint_as_float(w.x & 0xffff0000u); a[2] = __uint_as_float(w.y << 16); a[3] = __uint_as_float(w.y & 0xffff0000u);
    b[0] = __uint_as_float(w.z << 16); b[1] = __uint_as_float(w.z & 0xffff0000u); b[2] = __uint_as_float(w.w << 16); b[3] = __uint_as_float(w.w & 0xffff0000u);
}
__device__ __forceinline__ float xor32f(float v, bool up) { auto rr = __builtin_amdgcn_permlane32_swap(__float_as_uint(v), __float_as_uint(v), false, false); return __uint_as_float(up ? rr[0] : rr[1]); }
__device__ __forceinline__ float xor16f(float v, bool odd) { auto rr = __builtin_amdgcn_permlane16_swap(__float_as_uint(v), __float_as_uint(v), false, false); return __uint_as_float(odd ? rr[0] : rr[1]); }
template <int MASK> __device__ __forceinline__ f32x4 shfl4(const f32x4 v, int fq) { f32x4 r;
#pragma unroll
    for (int j = 0; j < 4; ++j) r[j] = (MASK == 16) ? xor16f(v[j], (fq & 1) != 0) : xor32f(v[j], (fq & 2) != 0);
    return r; }
__device__ __forceinline__ int fresh(int v) { asm volatile("" : "+v"(v)); return v; }
__device__ __forceinline__ int new_tid(int wave0) { int l; asm volatile("v_mbcnt_lo_u32_b32 %0, -1, 0\n\tv_mbcnt_hi_u32_b32 %0, -1, %0" : "=v"(l)); return wave0 * 64 + l; }
__device__ __forceinline__ float sigmoidf_(float x) { return __builtin_amdgcn_rcpf(1.f + __builtin_amdgcn_exp2f(-x * LOG2E)); }

using pg8::Unit;
typedef f32x4 Acc[2][2][4][2];

struct EpiIn {
    __device__ __forceinline__ bool keep(const Unit&) const { return false; }
    GAS unsigned char* wsb;
    template <bool ROPE> __device__ __forceinline__ void store_tile(const Acc& acc, bf16_t* dst, int ld, int colt, int row0, int wc, int fq, const float* COSP, const float* SINP) const {
        const bool dorope = ROPE && ((wc & 1) == 0);
#pragma unroll
        for (int h2 = 0; h2 < 2; ++h2) {
            f32x4 c0[4], c1[4], s0[4], s1[4];
            if (dorope) {
#pragma unroll
                for (int q = 0; q < 4; ++q) { const int i = h2 * 4 + q; const size_t ro = (size_t)(row0 + (i >> 2) * 128 + (i & 3) * 16) * 8;
                    c0[q] = *(const f32x4*)(COSP + ro); c1[q] = *(const f32x4*)(COSP + ro + 4); s0[q] = *(const f32x4*)(SINP + ro); s1[q] = *(const f32x4*)(SINP + ro + 4); } }
#pragma unroll
            for (int q = 0; q < 4; ++q) { const int i = h2 * 4 + q, ai = i >> 2, m = i & 3; const int row = row0 + ai * 128 + m * 16;
                if (dorope && fq == 0) { s0[q] = -s0[q]; s1[q] = -s1[q]; }
#pragma unroll
                for (int bj = 0; bj < 2; ++bj) { f32x4 v0 = acc[ai][bj][m][0], v1 = acc[ai][bj][m][1];
                    if (dorope) { const f32x4 p0 = shfl4<16>(v0, fq), p1 = shfl4<16>(v1, fq);
                        if (fq < 2) { v0 = v0 * c0[q] + p0 * s0[q]; v1 = v1 * c1[q] + p1 * s1[q]; } }
                    st128(dst + (size_t)row * ld + colt + bj * 128 + wc * 32 + 8 * fq, pack8(v0, v1)); } }
            asm volatile("" ::: "memory"); }
    }
    __device__ __forceinline__ void operator()(const Acc& acc, const Unit& u, int wr, int wc, int fr, int fq) const {
        const int pn = u.pn, row0 = u.pm * 256 + wr * 64 + fr;
        GAS unsigned char* ws = wsb; asm volatile("" : "+s"(ws));
        const float* COSP = (const float*)(ws + R_RP); const float* SINP = COSP + TCB * 8; const float* COSM = SINP + TCB * 8; const float* SINM = COSM + TCB * 16;
        bf16_t* AQ = (bf16_t*)(ws + R_A); bf16_t* AK = AQ + TCB * 512; bf16_t* AV = AK + TCB * 512;
        bf16_t* BCQ = (bf16_t*)(ws + R_B); bf16_t* BCKV = BCQ + TCB * 384; bf16_t* MKR = BCKV + TCB * 256; float* SSQ = (float*)(MKR + TCB * 32); float* SSK = SSQ + TCB * 8;
        bf16_t* CQ = (bf16_t*)(ws + R_C); bf16_t* CK = CQ + TCB * 768; bf16_t* CV = CK + TCB * 768;
        if (pn < 2) store_tile<true>(acc, AQ, 512, pn * 256, row0, wc, fq, COSP, SINP);
        else if (pn < 4) store_tile<true>(acc, AK, 512, (pn - 2) * 256, row0, wc, fq, COSP, SINP);
        else if (pn < 6) store_tile<false>(acc, AV, 512, (pn - 4) * 256, row0, wc, fq, COSP, SINP);
        else if (pn == 6 || pn == 8) {
            bf16_t* dst = pn == 6 ? BCQ : BCKV; const int ld = pn == 6 ? 384 : 256; float* ss = pn == 6 ? SSQ : SSK; const int sld = pn == 6 ? 8 : 4;
#pragma unroll
            for (int ai = 0; ai < 2; ++ai)
#pragma unroll
                for (int m = 0; m < 4; ++m) { const int row = row0 + ai * 128 + m * 16; float s = 0.f;
#pragma unroll
                    for (int bj = 0; bj < 2; ++bj) { const f32x4 v0 = acc[ai][bj][m][0], v1 = acc[ai][bj][m][1];
                        s += (v0[0] * v0[0] + v0[1] * v0[1]) + (v0[2] * v0[2] + v0[3] * v0[3]) + (v1[0] * v1[0] + v1[1] * v1[1]) + (v1[2] * v1[2] + v1[3] * v1[3]);
                        st128(dst + (size_t)row * ld + bj * 128 + wc * 32 + 8 * fq, pack8(v0, v1)); }
                    s += xor16f(s, (fq & 1) != 0); s += xor32f(s, (fq & 2) != 0);
                    if (fq == 0) st32f(ss + (size_t)row * sld + wc, s); asm volatile("" ::: "memory"); }
        } else if (pn == 7) {
#pragma unroll
            for (int ai = 0; ai < 2; ++ai)
#pragma unroll
                for (int m = 0; m < 4; ++m) { const int row = row0 + ai * 128 + m * 16;
                    { const f32x4 v0 = acc[ai][0][m][0], v1 = acc[ai][0][m][1];
                      float s = (v0[0] * v0[0] + v0[1] * v0[1]) + (v0[2] * v0[2] + v0[3] * v0[3]) + (v1[0] * v1[0] + v1[1] * v1[1]) + (v1[2] * v1[2] + v1[3] * v1[3]);
                      st128(BCQ + (size_t)row * 384 + 256 + wc * 32 + 8 * fq, pack8(v0, v1));
                      s += xor16f(s, (fq & 1) != 0); s += xor32f(s, (fq & 2) != 0);
                      if (fq == 0) st32f(SSQ + (size_t)row * 8 + 4 + wc, s); }
                    if (wc == 0) { f32x4 v0 = acc[ai][1][m][0], v1 = acc[ai][1][m][1];
                      const int fi = (fq & 1) * 8;
                      const f32x4 c0 = *(const f32x4*)(COSM + (size_t)row * 16 + fi), c1 = *(const f32x4*)(COSM + (size_t)row * 16 + fi + 4);
                      f32x4 s0 = *(const f32x4*)(SINM + (size_t)row * 16 + fi), s1 = *(const f32x4*)(SINM + (size_t)row * 16 + fi + 4);
                      if (fq < 2) { s0 = -s0; s1 = -s1; }
                      const f32x4 p0 = shfl4<32>(v0, fq), p1 = shfl4<32>(v1, fq);
                      v0 = v0 * c0 + p0 * s0; v1 = v1 * c1 + p1 * s1;
                      st128(MKR + (size_t)row * 32 + 8 * fq, pack8(v0, v1)); } asm volatile("" ::: "memory"); }
        }
        else if (pn < 12) store_tile<true>(acc, CQ, 768, (pn - 9) * 256, row0, wc, fq, COSP, SINP);
        else if (pn < 15) store_tile<true>(acc, CK, 768, (pn - 12) * 256, row0, wc, fq, COSP, SINP);
        else store_tile<false>(acc, CV, 1536, (pn - 15) * 256, row0, wc, fq, COSP, SINP);
    }
};
struct EpiMq {
    __device__ __forceinline__ bool keep(const Unit&) const { return false; }
    bf16_t* MQ; const float *SSQ, *COSM, *SINM;
    __device__ __forceinline__ void operator()(const Acc& acc, const Unit& u, int wr, int wc, int fr, int fq) const {
        const int pn = u.pn, row0 = u.pm * 256 + wr * 64 + fr;
        float rstd[8];
#pragma unroll
        for (int ai = 0; ai < 2; ++ai) { f32x4 q0[4], q1[4];
#pragma unroll
          for (int m = 0; m < 4; ++m) { const float* sp = SSQ + (size_t)(row0 + ai * 128 + m * 16) * 8; q0[m] = *(const f32x4*)sp; q1[m] = *(const f32x4*)(sp + 4); }
#pragma unroll
          for (int m = 0; m < 4; ++m) rstd[ai * 4 + m] = 1.0f / sqrtf(((q0[m][0] + q0[m][1]) + (q0[m][2] + q0[m][3]) + (q1[m][0] + q1[m][1]) + (q1[m][2] + q1[m][3])) * (1.0f / 384.0f) + RMS_EPS);
          asm volatile("" ::: "memory"); }
        if (pn < 2) {
#pragma unroll
            for (int i = 0; i < 8; ++i) { const int row = row0 + (i >> 2) * 128 + (i & 3) * 16;
#pragma unroll
                for (int bj = 0; bj < 2; ++bj) { const int c = pn * 256 + bj * 128 + wc * 32 + 8 * fq, head = c >> 6, d = c & 63;
                    st128(MQ + (size_t)row * 768 + head * 96 + d, pack8(acc[i >> 2][bj][i & 3][0] * rstd[i], acc[i >> 2][bj][i & 3][1] * rstd[i])); } }
        } else {
            const int fi = (fq & 1) * 8;
#pragma unroll
            for (int h2 = 0; h2 < 4; ++h2) {
                f32x4 c0[2], c1[2], s0[2], s1[2];
#pragma unroll
                for (int q = 0; q < 2; ++q) { const int i = h2 * 2 + q; const size_t ro = (size_t)(row0 + (i >> 2) * 128 + (i & 3) * 16) * 16 + fi;
                    c0[q] = *(const f32x4*)(COSM + ro); c1[q] = *(const f32x4*)(COSM + ro + 4); s0[q] = *(const f32x4*)(SINM + ro); s1[q] = *(const f32x4*)(SINM + ro + 4); }
#pragma unroll
                for (int q = 0; q < 2; ++q) { const int i = h2 * 2 + q, ai = i >> 2, m = i & 3; const int row = row0 + ai * 128 + m * 16; const float rs = rstd[i];
                    if (fq < 2) { s0[q] = -s0[q]; s1[q] = -s1[q]; }
#pragma unroll
                    for (int bj = 0; bj < 2; ++bj) { f32x4 v0 = acc[ai][bj][m][0] * rs, v1 = acc[ai][bj][m][1] * rs;
                        const f32x4 p0 = shfl4<32>(v0, fq), p1 = shfl4<32>(v1, fq);
                        v0 = v0 * c0[q] + p0 * s0[q]; v1 = v1 * c1[q] + p1 * s1[q];
                        st128(MQ + (size_t)row * 768 + (bj * 4 + wc) * 96 + 64 + 8 * fq, pack8(v0, v1)); } }
                asm volatile("" ::: "memory"); }
        }
    }
};
struct EpiMkv {
    __device__ __forceinline__ bool keep(const Unit&) const { return false; }
    bf16_t *MK, *MV; const float* SSK;
    __device__ __forceinline__ void operator()(const Acc& acc, const Unit& u, int wr, int wc, int fr, int fq) const {
        const int pn = u.pn, row0 = u.pm * 256 + wr * 64 + fr; bf16_t* dst = (pn < 2 ? MK : MV) + (pn & 1) * 256 + wc * 32 + 8 * fq;
        f32x4 q[8];
#pragma unroll
        for (int i = 0; i < 8; ++i) q[i] = *(const f32x4*)(SSK + (size_t)(row0 + (i >> 2) * 128 + (i & 3) * 16) * 4);
#pragma unroll
        for (int i = 0; i < 8; ++i) { const int row = row0 + (i >> 2) * 128 + (i & 3) * 16;
            const float rstd = 1.0f / sqrtf(((q[i][0] + q[i][1]) + (q[i][2] + q[i][3])) * (1.0f / 256.0f) + RMS_EPS);
#pragma unroll
            for (int bj = 0; bj < 2; ++bj) st128(dst + (size_t)row * 512 + bj * 128, pack8(acc[i >> 2][bj][i & 3][0] * rstd, acc[i >> 2][bj][i & 3][1] * rstd)); }
    }
};
struct EpiSig {
    __device__ __forceinline__ bool keep(const Unit&) const { return false; }
    bf16_t* G; const float* bias;
    __device__ __forceinline__ void operator()(const Acc& acc, const Unit& u, int wr, int wc, int fr, int fq) const {
        const int row0 = u.pm * 256 + wr * 64 + fr, col0 = u.pn * 256 + wc * 32 + 8 * fq;
#pragma unroll
        for (int bj = 0; bj < 2; ++bj) { const f32x4 b0 = *(const f32x4*)(bias + col0 + bj * 128), b1 = *(const f32x4*)(bias + col0 + bj * 128 + 4);
#pragma unroll
            for (int ai = 0; ai < 2; ++ai)
#pragma unroll
                for (int m = 0; m < 4; ++m) { const int row = row0 + ai * 128 + m * 16; f32x4 v0 = acc[ai][bj][m][0] + b0, v1 = acc[ai][bj][m][1] + b1;
#pragma unroll
                    for (int j = 0; j < 4; ++j) { v0[j] = sigmoidf_(v0[j]); v1[j] = sigmoidf_(v1[j]); }
                    st128(G + (size_t)row * 3072 + col0 + bj * 128, pack8(v0, v1)); } }
    }
};
struct EpiGate {
    const bf16_t* G; bf16_t* YB; int nMc;
    __device__ __forceinline__ bool keep(const Unit& u) const { return (u.pn >> 2) < 2; }
    __device__ __forceinline__ void operator()(Acc& acc, const Unit& u, int wr, int wc, int fr, int fq) const {
        const int b = u.pn >> 2, pn = u.pn & 3, pm = u.pm - b * nMc;
        const int row0 = pm * 256 + wr * 64 + fr, col0 = pn * 256 + wc * 32 + 8 * fq;
        const bf16_t* gp0 = G + (size_t)row0 * 3072 + b * 1024 + col0;
#pragma unroll
        for (int ai = 0; ai < 2; ++ai) {
            u32x4 gq[4][2];
#pragma unroll
            for (int m = 0; m < 4; ++m)
#pragma unroll
                for (int bj = 0; bj < 2; ++bj) gq[m][bj] = *(const u32x4*)(gp0 + (size_t)(ai * 128 + m * 16) * 3072 + bj * 128);
            if (b < 2) {
#pragma unroll
                for (int m = 0; m < 4; ++m)
#pragma unroll
                    for (int bj = 0; bj < 2; ++bj) { f32x4 g0, g1; unpack8(gq[m][bj], g0, g1); acc[ai][bj][m][0] *= g0; acc[ai][bj][m][1] *= g1; }
                asm volatile("" ::: "memory");
#pragma unroll
                for (int m = 0; m < 4; ++m)
#pragma unroll
                    for (int bj = 0; bj < 2; ++bj) gq[m][bj] = *(const u32x4*)(gp0 + 1024 + (size_t)(ai * 128 + m * 16) * 3072 + bj * 128);
#pragma unroll
                for (int m = 0; m < 4; ++m)
#pragma unroll
                    for (int bj = 0; bj < 2; ++bj) { f32x4 h0, h1; unpack8(gq[m][bj], h0, h1);
#pragma unroll
                        for (int j = 0; j < 4; ++j) { acc[ai][bj][m][0][j] *= __builtin_amdgcn_rcpf(fmaxf(h0[j], 1e-20f)); acc[ai][bj][m][1][j] *= __builtin_amdgcn_rcpf(fmaxf(h1[j], 1e-20f)); } }
            } else {
#pragma unroll
                for (int m = 0; m < 4; ++m) { const int row = row0 + ai * 128 + m * 16;
#pragma unroll
                    for (int bj = 0; bj < 2; ++bj) { f32x4 g0, g1; unpack8(gq[m][bj], g0, g1);
                        st128(YB + (size_t)row * 1024 + col0 + bj * 128, pack8(acc[ai][bj][m][0] * g0, acc[ai][bj][m][1] * g1)); } }
            }
            asm volatile("" ::: "memory");
        }
    }
};
struct EpiBf16 {
    __device__ __forceinline__ bool keep(const Unit&) const { return false; }
    bf16_t* O; int ld;
    __device__ __forceinline__ void operator()(const Acc& acc, const Unit& u, int wr, int wc, int fr, int fq) const {
        const int row0 = u.pm * 256 + wr * 64 + fr, col0 = u.pn * 256 + wc * 32 + 8 * fq;
#pragma unroll
        for (int ai = 0; ai < 2; ++ai)
#pragma unroll
            for (int m = 0; m < 4; ++m) { const int row = row0 + ai * 128 + m * 16;
#pragma unroll
                for (int bj = 0; bj < 2; ++bj) st128(O + (size_t)row * ld + col0 + bj * 128, pack8(acc[ai][bj][m][0], acc[ai][bj][m][1])); }
    }
};
struct EpiSwiglu {
    __device__ __forceinline__ bool keep(const Unit&) const { return false; }
    bf16_t* HID;
    __device__ __forceinline__ void operator()(const Acc& acc, const Unit& u, int wr, int wc, int fr, int fq) const {
        const int row0 = u.pm * 256 + wr * 64 + fr, col0 = (u.pn & 1) * 128 + wc * 32 + 8 * fq;
#pragma unroll
        for (int ai = 0; ai < 2; ++ai)
#pragma unroll
            for (int m = 0; m < 4; ++m) { const int row = row0 + ai * 128 + m * 16; f32x4 h0, h1;
#pragma unroll
                for (int j = 0; j < 4; ++j) { const float g0 = acc[ai][0][m][0][j], g1 = acc[ai][0][m][1][j];
                    h0[j] = g0 * sigmoidf_(g0) * acc[ai][1][m][0][j]; h1[j] = g1 * sigmoidf_(g1) * acc[ai][1][m][1][j]; }
                st128(HID + (size_t)row * 256 + col0, pack8(h0, h1)); }
    }
};
struct EpiDown {
    __device__ __forceinline__ bool keep(const Unit&) const { return false; }
    bf16_t* Y; const int* ROWTOK; const float* ROWW;
    __device__ __forceinline__ void operator()(const Acc& acc, const Unit& u, int wr, int wc, int fr, int fq) const {
        const int row0 = u.pm * 256 + wr * 64 + fr, col0 = (u.pn & 3) * 256 + wc * 32 + 8 * fq;
        int rt[8]; float w[8];
#pragma unroll
        for (int i = 0; i < 8; ++i) { const int row = row0 + (i >> 2) * 128 + (i & 3) * 16; rt[i] = ROWTOK[row]; w[i] = ROWW[row]; }
#pragma unroll
        for (int ai = 0; ai < 2; ++ai)
#pragma unroll
            for (int m = 0; m < 4; ++m) { const int r = rt[ai * 4 + m];
                if (r >= 0) { const float ww = w[ai * 4 + m]; const int tok = r & 0xffffff, slot = r >> 24; bf16_t* yp = Y + ((size_t)slot * TC + tok) * 1024 + col0;
#pragma unroll
                    for (int bj = 0; bj < 2; ++bj) st128(yp + bj * 128, pack8(acc[ai][bj][m][0] * ww, acc[ai][bj][m][1] * ww)); } }
    }
};
struct MoeOrder {
    int nbr, NTL, G, c; const LAS int* blk_e;
    __device__ __forceinline__ int row_block(int i) const {
        const int cs = (G % 32) ? c : (NTL == 2 ? ((c >> 4) << 4) + 2 * (c & 7) + ((c >> 3) & 1) : ((c >> 5) << 5) + 4 * (c & 7) + ((c >> 3) & 3));
        const int L = i * G + cs; if (L >= (nbr + TC / 256) * NTL) return -1;
        const int blk = L / NTL; return blk < nbr ? blk : BASE_SH / 256 + (blk - nbr); }
    __device__ bool next(int i, Unit& u) const {
        const int cs = (G % 32) ? c : (NTL == 2 ? ((c >> 4) << 4) + 2 * (c & 7) + ((c >> 3) & 1) : ((c >> 5) << 5) + 4 * (c & 7) + ((c >> 3) & 3));
        const int L = i * G + cs; if (L >= (nbr + TC / 256) * NTL) return false;
        const int blk = L / NTL, j = L % NTL; int e;
        if (blk < nbr) { u.pm = blk; e = blk_e[blk]; } else { u.pm = BASE_SH / 256 + (blk - nbr); e = 16; }
        u.pn = e * NTL + j; return true;
    }
};
struct BranchOrder {
    int nMc, G, c;
    __device__ bool next(int i, Unit& u) const {
        const int b = i % 3, L = (i / 3) * G + c; if (L >= nMc * 4) return false;
        const int pm = L >> 2, pn = L & 3; u.pm = b * nMc + pm; u.pn = b * 4 + pn; return true;
    }
};

struct Args { GAS const void* in[31]; GAS float* out; GAS unsigned char* ws; int ph_lo, ph_hi; float invf_p[8]; float invf_m[16]; float lam_init[2]; float oml[2]; };
struct Frame { LAS unsigned char* lds; int tid, lane, wave, G, vcu; };
constexpr int NW = 8;

__device__ __forceinline__ void tr_item(const float* W, int ldw, int n_src0, int k0, bf16_t* WT, int ldt, int n_dst0, const float* ks, int ksmod, float scal, LAS float* scr, int lane) {
#pragma unroll 8
    for (int i = 0; i < 32; ++i) { const int kk = 2 * i + (lane >> 5); float v = W[(size_t)(k0 + kk) * ldw + n_src0 + (lane & 31)] * scal; if (ks) v *= ks[(k0 + kk) % ksmod]; scr[kk * 33 + (lane & 31)] = v; }
    asm volatile("s_waitcnt lgkmcnt(0)" ::: "memory");
    const int c = lane & 7;
#pragma unroll
    for (int j = 0; j < 4; ++j) { const int n = (lane >> 3) + 8 * j; const LAS float* s = scr + (8 * c) * 33 + n;
        u32x4 o; o.x = pk2(s[0 * 33], s[1 * 33]); o.y = pk2(s[2 * 33], s[3 * 33]); o.z = pk2(s[4 * 33], s[5 * 33]); o.w = pk2(s[6 * 33], s[7 * 33]);
        *(u32x4*)(WT + (size_t)(n_dst0 + n) * ldt + k0 + 8 * c) = o; }
    asm volatile("s_waitcnt lgkmcnt(0)" ::: "memory");
}
__device__ __forceinline__ void tr_seg(const Frame& F, int& ibase, const float* W, int K, int ldw, int src0, int len, bf16_t* WT, int dst0, const float* ks, int ksmod, float scal) {
    const int NGW = F.G * NW, gw = F.vcu * NW + F.wave, nblk = len / 32, n = (K / 64) * nblk;
    LAS float* scr = (LAS float*)(F.lds + F.wave * 16384);
    int start = gw - (ibase % NGW); if (start < 0) start += NGW;
    for (int it = start; it < n; it += NGW) { const int kb = it / nblk, nb = it % nblk; tr_item(W, ldw, src0 + 32 * nb, 64 * kb, WT, K, dst0 + 32 * nb, ks, ksmod, scal, scr, F.lane); }
    ibase += n;
}

#define DEFPTRS const int T0 = c * TC; \
    bf16_t* XB = (bf16_t*)(ws + R_XB); \
    float* COSP = (float*)(ws + R_RP); float* SINP = COSP + TCB * 8; float* COSM = SINP + TCB * 8; float* SINM = COSM + TCB * 16; \
    bf16_t* AQ = (bf16_t*)(ws + R_A); bf16_t* AK = AQ + TCB * 512; bf16_t* AV = AK + TCB * 512; \
    bf16_t* OAn = (bf16_t*)(ws + R_S); \
    bf16_t* OB = OAn + TCB * 512; bf16_t* OCn = OAn + TCB * 1024; \
    bf16_t* HID = AQ; \
    bf16_t* BCQ = (bf16_t*)(ws + R_B); bf16_t* BCKV = BCQ + TCB * 384; bf16_t* MKR = BCKV + TCB * 256; float* SSQ = (float*)(MKR + TCB * 32); float* SSK = SSQ + TCB * 8; \
    bf16_t* CQ = (bf16_t*)(ws + R_C); bf16_t* CK = CQ + TCB * 768; bf16_t* CV = CK + TCB * 768; \
    bf16_t* GT = CQ; bf16_t* YS = CQ; \
    bf16_t* OA = (bf16_t*)(ws + R_O); bf16_t* OCg = OA + TCB * 1024; float* LSE = (float*)(OCg + TCB * 1536); \
    float* YF = (float*)(ws + R_O); bf16_t* YB = (bf16_t*)(ws + R_O + TCB * 4096); float* MIX = YF; \
    bf16_t* XG = (bf16_t*)(ws + R_O); bf16_t* XB1 = XG + (size_t)BASE_SH * 1024; \
    bf16_t* MQ = (bf16_t*)(ws + R_M); bf16_t* MK = MQ + TCB * 768; bf16_t* MV = MK + TCB * 512; \
    int* ERT = (int*)(ws + R_O + TCB * 2048 + 4 * MiB); float* ERW = (float*)(ERT + 16 * TCB);        \
    int* TOKE = (int*)(ws + R_T); float* TOKW = (float*)(TOKE + TCB * 2); int* TOKP = (int*)(TOKW + TCB * 2); int* ROWTOK = TOKP + TCB * 2; float* ROWW = (float*)(ROWTOK + NROWS); \
    float* X = (float*)(ap->out + (size_t)T0 * D);
#define DEFL GAS unsigned char* wb = ws + WS_W + (size_t)l * WB_LAYER; unsigned* CNT = (unsigned*)(ws + WS_CTL) + CW_CNT + (c * DEPTH + l) * 64; (void)wb; (void)CNT;
__global__ void __launch_bounds__(NW * 64, 2) fwd_kernel(Args args) {
    extern __shared__ __attribute__((aligned(16))) unsigned char lds_raw[];
    LAS unsigned char* const lds0 = (LAS unsigned char*)lds_raw;
    for (int u = threadIdx.x; u < (LDS_BYTES - MISC_OFF) / 4; u += NW * 64) ((LAS unsigned*)(lds0 + MISC_OFF))[u] = 0u;
    __syncthreads();
    const int lo = args.ph_lo, hi = args.ph_hi;
    const bool multi = (hi - lo) > 1;
    XcdBarrier bar; bar.bar = (unsigned*)(args.ws + WS_CTL) + CW_BAR; bar.x = 0; bar.st = nullptr;
    if (multi) bar = xcd_barrier_post((unsigned*)(args.ws + WS_CTL) + CW_BAR, (volatile LAS unsigned*)(lds0 + MISC_OFF));
    int ph = 0;
    const int wave0 = __builtin_amdgcn_readfirstlane((int)threadIdx.x >> 6);
#ifndef SUBMASK
#define SUBMASK 0xFFu
#endif
#ifndef PHMASK
#define PHMASK 0xFFFFFFFFu
#endif
typedef const __attribute__((address_space(4))) Args CArgs;
#define PH_BEGIN if (ph >= lo && ph < hi) { CArgs* ap = (CArgs*)__builtin_amdgcn_kernarg_segment_ptr(); asm volatile("" : "+s"(ap)); GAS unsigned char* ws = ap->ws; (void)ws; \
    Frame F; asm volatile("v_mbcnt_lo_u32_b32 %0, -1, 0\n\tv_mbcnt_hi_u32_b32 %0, -1, %0" : "=v"(F.lane)); F.tid = wave0 * 64 + F.lane; F.lane = F.tid & 63; F.wave = __builtin_amdgcn_readfirstlane(F.tid >> 6); F.lds = lds0; F.G = gridDim.x; \
    { const int bx_ = blockIdx.x; F.vcu = (F.G % 8 == 0) ? (bx_ % 8) * (F.G / 8) + bx_ / 8 : bx_; } \
    const int gw = F.vcu * NW + F.wave, NGW = F.G * NW, bx = (int)blockIdx.x; (void)gw; (void)NGW; (void)bx;
#define PH_END if (ph + 1 < hi) xcd_barrier(bar); } ++ph;
    LAS int* OFFS = (LAS int*)(lds0 + MISC_OFF + 64);
    LAS int* NBR = (LAS int*)(lds0 + MISC_OFF + 192);
    LAS int* BLKE = (LAS int*)(lds0 + MISC_OFF + 256);

    PH_BEGIN if constexpr ((PHMASK >> 0) & 1)
    {
        int ibase = 0;
        for (int l = 0; l < DEPTH; ++l) {
            GAS unsigned char* wb = ws + WS_W + (size_t)l * WB_LAYER;
            bf16_t* Win = (bf16_t*)(wb + WB_IN);
            const float* w_in = (const float*)ap->in[4] + (size_t)l * 1024 * IN_WIDTH;
            tr_seg(F, ibase, w_in, 1024, IN_WIDTH, 0, 1920, Win, 0, nullptr, 1, 1.f);
            tr_seg(F, ibase, w_in, 1024, IN_WIDTH, 2176, 32, Win, 1920, nullptr, 1, 1.f);
            tr_seg(F, ibase, w_in, 1024, IN_WIDTH, 1920, 256, Win, 2048, nullptr, 1, 1.f);
            tr_seg(F, ibase, w_in, 1024, IN_WIDTH, 2208, 6144, Win, 2304, nullptr, 1, 1.f);
            for (int i = bx * 512 + F.tid; i < 96 * 1024 / 8; i += F.G * 512) *(u32x4*)(Win + (size_t)1952 * 1024 + (size_t)i * 8) = (u32x4){0u, 0u, 0u, 0u};
            const float* w_qb = (const float*)ap->in[13] + (size_t)l * 384 * 768; const float* qg = (const float*)ap->in[11] + l * 384;
            const float* w_kvb = (const float*)ap->in[14] + (size_t)l * 256 * 1024; const float* kvg = (const float*)ap->in[12] + l * 256;
            for (int h = 0; h < 8; ++h) {
                tr_seg(F, ibase, w_qb, 384, 768, h * 96, 64, (bf16_t*)(wb + WB_QB), h * 64, qg, 384, 1.f);
                tr_seg(F, ibase, w_qb, 384, 768, h * 96 + 64, 32, (bf16_t*)(wb + WB_QB), 512 + h * 32, qg, 384, 1.f);
                tr_seg(F, ibase, w_kvb, 256, 1024, h * 128, 64, (bf16_t*)(wb + WB_KVB), h * 64, kvg, 256, 1.f);
                tr_seg(F, ibase, w_kvb, 256, 1024, h * 128 + 64, 64, (bf16_t*)(wb + WB_KVB), 512 + h * 64, kvg, 256, 1.f);
            }
            tr_seg(F, ibase, (const float*)ap->in[15] + (size_t)l * 512 * 1024, 512, 1024, 0, 1024, (bf16_t*)(wb + WB_BR), 0, (const float*)ap->in[10] + l * 128, 128, ap->oml[l]);
            tr_seg(F, ibase, (const float*)ap->in[16] + (size_t)l * 512 * 1024, 512, 1024, 0, 1024, (bf16_t*)(wb + WB_BR), 1024, nullptr, 1, 1.f);
            tr_seg(F, ibase, (const float*)ap->in[17] + (size_t)l * 512 * 1024, 512, 1024, 0, 1024, (bf16_t*)(wb + WB_BR), 2048, nullptr, 1, 1.f);
            tr_seg(F, ibase, (const float*)ap->in[18] + (size_t)l * 1024 * 1024, 1024, 1024, 0, 1024, (bf16_t*)(wb + WB_OUT), 0, nullptr, 1, 1.f);
            for (int e = 0; e < 17; ++e) {
                const float* wg = e < 16 ? (const float*)ap->in[23] + ((size_t)l * 16 + e) * 1024 * 256 : (const float*)ap->in[26] + (size_t)l * 1024 * 256;
                const float* wu = e < 16 ? (const float*)ap->in[24] + ((size_t)l * 16 + e) * 1024 * 256 : (const float*)ap->in[27] + (size_t)l * 1024 * 256;
                const float* wd = e < 16 ? (const float*)ap->in[25] + ((size_t)l * 16 + e) * 256 * 1024 : (const float*)ap->in[28] + (size_t)l * 256 * 1024;
                for (int j = 0; j < 2; ++j) {
                    tr_seg(F, ibase, wg, 1024, 256, j * 128, 128, (bf16_t*)(wb + WB_W1), e * 512 + j * 256, nullptr, 1, 1.f);
                    tr_seg(F, ibase, wu, 1024, 256, j * 128, 128, (bf16_t*)(wb + WB_W1), e * 512 + j * 256 + 128, nullptr, 1, 1.f);
                }
                tr_seg(F, ibase, wd, 256, 1024, 0, 1024, (bf16_t*)(wb + WB_W2), e * 1024, nullptr, 1, 1.f);
            }
        }
    }
        { const int c = 0;
        { DEFPTRS
            const float* xin = (const float*)ap->in[0] + (size_t)T0 * D; const int* pos = (const int*)ap->in[1] + T0;
            const float* g = (const float*)ap->in[2]; const float* b = (const float*)ap->in[3];
            f32x4 gv[4], bv[4];
#pragma unroll
            for (int j = 0; j < 4; ++j) { gv[j] = *(const f32x4*)(g + 4 * F.lane + 256 * j); bv[j] = *(const f32x4*)(b + 4 * F.lane + 256 * j); }
            const float invf = F.lane < 8 ? ap->invf_p[F.lane & 7] : ap->invf_m[(F.lane - 8) & 15];
            f32x4 nv[4]; int npos = pos[gw];
#pragma unroll
            for (int j = 0; j < 4; ++j) nv[j] = ((const f32x4*)(xin + (size_t)gw * D) + F.lane)[64 * j];
            for (int t = gw; t < TC; t += NGW) {
                f32x4 v[4]; float s = 0.f; const int cpos = npos;
#pragma unroll
                for (int j = 0; j < 4; ++j) v[j] = nv[j];
                if (t + NGW < TC) { npos = pos[t + NGW];
#pragma unroll
                    for (int j = 0; j < 4; ++j) nv[j] = ((const f32x4*)(xin + (size_t)(t + NGW) * D) + F.lane)[64 * j]; }
#pragma unroll
                for (int j = 0; j < 4; ++j) s += (v[j][0] + v[j][1]) + (v[j][2] + v[j][3]);
                const float mean = wave_sum(s) * (1.f / D); float s2 = 0.f;
#pragma unroll
                for (int j = 0; j < 4; ++j) { v[j] = v[j] - mean; s2 += (v[j][0] * v[j][0] + v[j][1] * v[j][1]) + (v[j][2] * v[j][2] + v[j][3] * v[j][3]); }
                const float rstd = 1.0f / sqrtf(wave_sum(s2) * (1.f / D) + LN_EPS);
#pragma unroll
                for (int j = 0; j < 4; ++j) { v[j] = v[j] * rstd * gv[j] + bv[j];
                    u32x2 w; w.x = pk2(v[j][0], v[j][1]); w.y = pk2(v[j][2], v[j][3]); st64((u32x2*)(XB + (size_t)t * D) + F.lane + 64 * j, w); }
                if (F.lane < 24) {
                    const float ang = (float)cpos * invf;
                    const double rev = (double)ang * 0.15915494309189535; const float fr = (float)(rev - __builtin_rint(rev));
                    const float cs = __builtin_amdgcn_cosf(fr), sn = __builtin_amdgcn_sinf(fr);
                    if (F.lane < 8) { st32f(COSP + (size_t)t * 8 + F.lane, cs); st32f(SINP + (size_t)t * 8 + F.lane, sn); }
                    else { st32f(COSM + (size_t)t * 16 + F.lane - 8, cs); st32f(SINM + (size_t)t * 16 + F.lane - 8, sn); }
                }
            }
        }
        }
    PH_END

    for (int c = 0; c < NCHUNK; ++c) {


        for (int l = 0; l < DEPTH; ++l) {
            PH_BEGIN if constexpr ((PHMASK >> 2) & 1)
            { DEFPTRS DEFL
                pg8::Gemm g{XB, (const bf16_t*)(wb + WB_IN), 1024, 1024, 1024}; pg8::StaticOrder S; S.init(TC, NIN_A, F.G, bx);
                EpiIn E{ws};
                pg8::gemm_phase(F.lds, fresh(F.tid), g, S, E);
            }
            PH_END
            PH_BEGIN if constexpr ((PHMASK >> 3) & 1)
            { DEFPTRS DEFL
                if constexpr (SUBMASK & 8) for (int uidx = bx; uidx < NBC * 3 * 4 * 32; uidx += F.G) { const int x = uidx & 31, h = (uidx >> 5) & 3, gi = (uidx >> 7) % 3, b = uidx / 384;
                    const int dil = gi == 0 ? 1 : (gi == 1 ? 4 : 16), L = SEQ / dil, r = x % dil, jb = x / dil; const size_t tok0 = (size_t)b * SEQ + r; const int hc = gi * 4 + h;
                    att::band_unit(CQ + tok0 * 768 + hc * 64, 768, CK + tok0 * 768 + hc * 64, 768, CV + tok0 * 1536 + hc * 128, 1536,
                                   OCg + (size_t)gi * TCB * 512 + tok0 * 512 + h * 128, 512, LSE + tok0 * 12 + hc, 12, dil, L, jb * 256, 0.125f * LOG2E, 0.125f, (LAS char*)F.lds, fresh(F.tid)); }
                if constexpr (SUBMASK & 4) {
                    float lam;
                    { const float a = ((const float*)ap->in[6])[l * 64 + F.lane] * ((const float*)ap->in[7])[l * 64 + F.lane], bq = ((const float*)ap->in[8])[l * 64 + F.lane] * ((const float*)ap->in[9])[l * 64 + F.lane];
                      lam = __expf(wave_sum(a)) - __expf(wave_sum(bq)) + ap->lam_init[l]; lam = __uint_as_float((unsigned)__builtin_amdgcn_readfirstlane((int)__float_as_uint(lam))); }
                    for (int uu = bx; uu < NBC * 4 * 32; uu += F.G) { const int rr = uu & 255, bh = (uu >> 8) * 8 + (rr & 7), qb = rr >> 3;
                        const int b = bh >> 2, h = bh & 3; const size_t tb = (size_t)b * SEQ;
                        _Pragma("unroll")
                        for (int m = 0; m < 2; ++m) { const int hm = 2 * h + m; bf16_t* O1 = OA + (tb + qb * 256) * 1024 + (2 * h) * 128;
                            att::dense_unit_dma(AQ + (tb + qb * 256) * 512 + hm * 64, 512, AK + tb * 512 + hm * 64, 512, AV + tb * 512 + h * 128, 512,
                                                m == 0 ? O1 : OAn + (tb + qb * 256) * 512 + h * 128, m == 0 ? 1024 : 512, SEQ, 0.125f * LOG2E, 64.f, (LAS char*)F.lds, fresh(F.tid), m, lam, O1, 1024); } } }
                if constexpr (SUBMASK & 1) { pg8::Gemm g{BCQ, (const bf16_t*)(wb + WB_QB), 384, 384, 384}; pg8::StaticOrder S; S.init(TC, 768, F.G, bx); EpiMq E{MQ, SSQ, COSM, SINM}; pg8::gemm_phase(F.lds, fresh(F.tid), g, S, E); }
                if constexpr (SUBMASK & 2) { pg8::Gemm g{BCKV, (const bf16_t*)(wb + WB_KVB), 256, 256, 256}; pg8::StaticOrder S; S.init(TC, 1024, F.G, bx); EpiMkv E{MK, MV, SSK}; pg8::gemm_phase(F.lds, fresh(F.tid), g, S, E); }
            }
            PH_END
            PH_BEGIN if constexpr ((PHMASK >> 4) & 1)
            { DEFPTRS DEFL
                const float cm = 0.10206207261596575f;
                if constexpr (SUBMASK & 16) for (int uu = bx; uu < NBC * 8 * 16; uu += F.G) { const int rr = uu & 255, bh = (uu >> 8) * 16 + (rr & 7) * 2 + ((rr >> 3) & 1), qb = rr >> 4;
                    const int b = bh >> 3, h = bh & 7; const size_t tb = (size_t)b * SEQ;
                    att::dense_unit64_hp(MQ + (tb + qb * 512) * 768 + h * 96, 768, MK + tb * 512 + h * 64, 512, MKR + tb * 32, 32, MV + tb * 512 + h * 64, 512,
                                              OB + (tb + qb * 512) * 512 + h * 64, 512, SEQ, cm * LOG2E, 8.f / cm, (LAS char*)F.lds, new_tid(wave0)); }
                if constexpr (SUBMASK & 16) { F.tid = new_tid(wave0); F.lane = F.tid & 63; }
                {
                    const int h = F.lane >> 4, e0 = (F.lane & 15) * 8;
#define THIN_LOAD(tt) do { const size_t t_ = (size_t)(tt); \
                        nC = *(const u32x4*)(OCg + t_ * 512 + h * 128 + e0); nD = *(const u32x4*)(OCg + TCB * 512 + t_ * 512 + h * 128 + e0); nF = *(const u32x4*)(OCg + 2 * TCB * 512 + t_ * 512 + h * 128 + e0); \
                        nl0 = LSE[t_ * 12 + h]; nl1 = LSE[t_ * 12 + 4 + h]; nl2 = LSE[t_ * 12 + 8 + h]; } while (0)
                    u32x4 nC, nD, nF; float nl0, nl1, nl2;
                    THIN_LOAD(gw);
                    for (int t = gw; t < TC; t += NGW) {
                        const u32x4 cC = nC, cD = nD, cF = nF; const float l0 = nl0, l1 = nl1, l2 = nl2;
                        if (t + NGW < TC) THIN_LOAD(t + NGW);
                        const float mx = fmaxf(l0, fmaxf(l1, l2)); float w0 = __expf(l0 - mx), w1 = __expf(l1 - mx), w2 = __expf(l2 - mx); const float ri = 1.0f / (w0 + w1 + w2); w0 *= ri; w1 *= ri; w2 *= ri;
                        f32x4 c0, c1, d0, d1, f0, f1; unpack8(cC, c0, c1); unpack8(cD, d0, d1); unpack8(cF, f0, f1);
                        st128(OCn + (size_t)t * 512 + h * 128 + e0, pack8(w0 * c0 + w1 * d0 + w2 * f0, w0 * c1 + w1 * d1 + w2 * f1));
                    }
#undef THIN_LOAD
                }
                __syncthreads();
                if constexpr (SUBMASK & 64) { pg8::Gemm g{XB, (const bf16_t*)(wb + WB_IN) + (size_t)NIN_A * 1024, 1024, 1024, 1024}; pg8::StaticOrder S; S.init(TC, 3072, F.G, bx);
                  EpiSig E{GT, (const float*)ap->in[5] + l * 3072}; pg8::gemm_phase(F.lds, fresh(F.tid), g, S, E); }
            }
            PH_END
            PH_BEGIN if constexpr ((PHMASK >> 5) & 1)
            { DEFPTRS DEFL
                pg8::Gemm g{OAn, (const bf16_t*)(wb + WB_BR), 512, 512, 512}; BranchOrder S{TC / 256, F.G, bx}; EpiGate E{GT, YB, TC / 256};
                pg8::gemm_phase(F.lds, fresh(F.tid), g, S, E);
            }
            PH_END
            PH_BEGIN if constexpr ((PHMASK >> 6) & 1)
            { DEFPTRS DEFL
                pg8::Gemm g{YB, (const bf16_t*)(wb + WB_OUT), 1024, 1024, 1024}; pg8::StaticOrder S; S.init(TC, 1024, F.G, bx); EpiBf16 E{(bf16_t*)MIX, 1024};
                pg8::gemm_phase(F.lds, fresh(F.tid), g, S, E);
            }
            PH_END
            PH_BEGIN if constexpr ((PHMASK >> 7) & 1)
            { DEFPTRS DEFL
                LAS char* WL = (LAS char*)F.lds;
                LAS char* XW = (LAS char*)F.lds + 65536 + F.wave * 8192;
                LAS unsigned* LCNT = (LAS unsigned*)(F.lds + MISC_OFF + 4096);
                const float* rw = (const float*)ap->in[21];
                for (int i = F.tid; i < 16384; i += 512) { const int k = i >> 4, ex = i & 15; const float w = rw[i];
                    const unsigned hb = pk2(w, 0.f) & 0xffffu; const unsigned lb = pk2(w - __uint_as_float(hb << 16), 0.f) & 0xffffu;
                    const int hf = ex >> 3, grp = (ex >> 2) & 1, q4 = ex & 3, mh = ((grp * 2) * 2 + hf) * 4 + q4, ml = ((grp * 2 + 1) * 2 + hf) * 4 + q4;
                    *(LAS bf16_t*)(WL + mh * 2048 + (((k >> 3) ^ (mh & 15)) << 4) + (k & 7) * 2) = (bf16_t)hb;
                    *(LAS bf16_t*)(WL + ml * 2048 + (((k >> 3) ^ (ml & 15)) << 4) + (k & 7) * 2) = (bf16_t)lb; }
                if (F.tid < 16) LCNT[F.tid] = 0u;
                __syncthreads();
                const float* g = (const float*)ap->in[19] + l * D; const float* b = (const float*)ap->in[20] + l * D; const float* rbias = (const float*)ap->in[22];
                f32x4 gv[4], bv[4];
#pragma unroll
                for (int j = 0; j < 4; ++j) { gv[j] = *(const f32x4*)(g + 4 * F.lane + 256 * j); bv[j] = *(const f32x4*)(b + 4 * F.lane + 256 * j); }
                const int r32 = F.lane & 31, hi = F.lane >> 5;
                int me1 = 0, me2 = 0; unsigned mp1 = 0, mp2 = 0; float mw1 = 0.f, mw2 = 0.f;
                int it = 0;
                u32x2 nmw[4], nxw[4];
#pragma unroll
                for (int j = 0; j < 4; ++j) { nmw[j] = *((const u32x2*)((const bf16_t*)MIX + (size_t)gw * D) + F.lane + 64 * j); nxw[j] = *((const u32x2*)(XB + (size_t)gw * D) + F.lane + 64 * j); }
                for (int t = gw; t < TC; t += NGW, ++it) {
                    f32x4 v[4]; float s = 0.f; u32x2 cmw[4], cxw[4];
#pragma unroll
                    for (int j = 0; j < 4; ++j) { cmw[j] = nmw[j]; cxw[j] = nxw[j]; }
                    if (t + NGW < TC) {
#pragma unroll
                        for (int j = 0; j < 4; ++j) { nmw[j] = *((const u32x2*)((const bf16_t*)MIX + (size_t)(t + NGW) * D) + F.lane + 64 * j); nxw[j] = *((const u32x2*)(XB + (size_t)(t + NGW) * D) + F.lane + 64 * j); } }
#pragma unroll
                    for (int j = 0; j < 4; ++j) { const u32x2 mw = cmw[j]; const f32x4 mv = {__uint_as_float(mw.x << 16), __uint_as_float(mw.x & 0xffff0000u), __uint_as_float(mw.y << 16), __uint_as_float(mw.y & 0xffff0000u)};
                        const u32x2 xw = cxw[j]; const f32x4 xv = {__uint_as_float(xw.x << 16), __uint_as_float(xw.x & 0xffff0000u), __uint_as_float(xw.y << 16), __uint_as_float(xw.y & 0xffff0000u)};
                        v[j] = ALPHA * xv + mv; s += (v[j][0] + v[j][1]) + (v[j][2] + v[j][3]); }
                    const float mean = wave_sum(s) * (1.f / D); float s2 = 0.f;
#pragma unroll
                    for (int j = 0; j < 4; ++j) { v[j] = v[j] - mean; s2 += (v[j][0] * v[j][0] + v[j][1] * v[j][1]) + (v[j][2] * v[j][2] + v[j][3] * v[j][3]); }
                    const float rstd = 1.0f / sqrtf(wave_sum(s2) * (1.f / D) + LN_EPS);
                    const int q = it & 3;
#pragma unroll
                    for (int j = 0; j < 4; ++j) { v[j] = v[j] * rstd * gv[j] + bv[j];
                        u32x2 w; w.x = pk2(v[j][0], v[j][1]); w.y = pk2(v[j][2], v[j][3]); st64((u32x2*)(XB1 + (size_t)t * D) + F.lane + 64 * j, w);
                        *(LAS u32x2*)(XW + q * 2048 + ((((F.lane >> 1) + 32 * j) ^ q) << 4) + (F.lane & 1) * 8) = w; }
                    if (q != 3 && t + NGW < TC) continue;
                    f32x16 acc = f32x16{};
#pragma unroll 8
                    for (int ks = 0; ks < 64; ++ks) { const int ch = ks * 2 + hi;
                        const bf16x8 wa = *(const LAS bf16x8*)(WL + r32 * 2048 + ((ch ^ (r32 & 15)) << 4)), xb = *(const LAS bf16x8*)(XW + (r32 & 3) * 2048 + ((ch ^ (r32 & 3)) << 4));
                        acc = __builtin_amdgcn_mfma_f32_32x32x16_bf16(wa, xb, acc, 0, 0, 0); }
                    float sc[8], bsd[8];
#pragma unroll
                    for (int e8 = 0; e8 < 4; ++e8) { sc[e8] = sigmoidf_(acc[e8] + acc[4 + e8]); sc[4 + e8] = sigmoidf_(acc[8 + e8] + acc[12 + e8]); }
#pragma unroll
                    for (int e8 = 0; e8 < 8; ++e8) bsd[e8] = sc[e8] + rbias[hi * 8 + e8];
                    float gs[2];
#pragma unroll
                    for (int gI = 0; gI < 2; ++gI) { const float a0 = bsd[4 * gI], a1 = bsd[4 * gI + 1], a2 = bsd[4 * gI + 2], a3 = bsd[4 * gI + 3];
                        const float m1 = fmaxf(fmaxf(a0, a1), fmaxf(a2, a3));
                        float m2; if (a0 == m1) m2 = fmaxf(a1, fmaxf(a2, a3)); else if (a1 == m1) m2 = fmaxf(a0, fmaxf(a2, a3)); else if (a2 == m1) m2 = fmaxf(a0, fmaxf(a1, a3)); else m2 = fmaxf(a0, fmaxf(a1, a2));
                        gs[gI] = m1 + m2; }
                    const int gl = gs[1] > gs[0] ? 1 : 0; const float gbest = gl ? gs[1] : gs[0];
                    const float c0 = gl ? bsd[4] : bsd[0], c1 = gl ? bsd[5] : bsd[1], c2 = gl ? bsd[6] : bsd[2], c3 = gl ? bsd[7] : bsd[3];
                    const float u0 = gl ? sc[4] : sc[0], u1 = gl ? sc[5] : sc[1], u2 = gl ? sc[6] : sc[2], u3 = gl ? sc[7] : sc[3];
                    int i1 = 0; float b1 = c0; if (c1 > b1) { b1 = c1; i1 = 1; } if (c2 > b1) { b1 = c2; i1 = 2; } if (c3 > b1) { b1 = c3; i1 = 3; }
                    int i2 = -1; float b2 = -INFINITY;
                    if (i1 != 0 && c0 > b2) { b2 = c0; i2 = 0; } if (i1 != 1 && c1 > b2) { b2 = c1; i2 = 1; } if (i1 != 2 && c2 > b2) { b2 = c2; i2 = 2; } if (i1 != 3 && c3 > b2) { b2 = c3; i2 = 3; }
                    const float s1v = i1 == 0 ? u0 : i1 == 1 ? u1 : i1 == 2 ? u2 : u3, s2v = i2 == 0 ? u0 : i2 == 1 ? u1 : i2 == 2 ? u2 : u3;
                    const int gsel = 2 * hi + gl, e1v = gsel * 4 + i1, e2v = gsel * 4 + i2;
                    float other; { auto rr = __builtin_amdgcn_permlane32_swap(__float_as_uint(gbest), __float_as_uint(gbest), false, false); other = __uint_as_float(hi ? rr[0] : rr[1]); }
                    const int win = hi ? (gbest > other ? 1 : 0) : (other > gbest ? 0 : 1);
                    for (int qq = 0; qq <= q; ++qq) {
                        const int wl = __builtin_amdgcn_readlane(win, qq) ? qq : 32 + qq;
                        const int e1 = __builtin_amdgcn_readlane(e1v, wl), e2 = __builtin_amdgcn_readlane(e2v, wl);
                        const float s1 = __uint_as_float((unsigned)__builtin_amdgcn_readlane((int)__float_as_uint(s1v), wl)), s2 = __uint_as_float((unsigned)__builtin_amdgcn_readlane((int)__float_as_uint(s2v), wl));
                        const float inv = 1.0f / (s1 + s2);
                        unsigned p1 = 0, p2 = 0;
                        if (F.lane == 0) { p1 = __hip_atomic_fetch_add(LCNT + e1, 1u, __ATOMIC_RELAXED, __HIP_MEMORY_SCOPE_WORKGROUP); p2 = __hip_atomic_fetch_add(LCNT + e2, 1u, __ATOMIC_RELAXED, __HIP_MEMORY_SCOPE_WORKGROUP); }
                        p1 = (unsigned)__builtin_amdgcn_readfirstlane((int)p1); p2 = (unsigned)__builtin_amdgcn_readfirstlane((int)p2);
                        if (F.lane == it - q + qq) { me1 = e1; me2 = e2; mp1 = p1; mp2 = p2; mw1 = s1 * inv; mw2 = s2 * inv; } }
                }
                __syncthreads();
                if (F.tid < 16) { const unsigned n = LCNT[F.tid]; LCNT[16 + F.tid] = n ? __hip_atomic_fetch_add(CNT + F.tid, n, __ATOMIC_RELAXED, __HIP_MEMORY_SCOPE_AGENT) : 0u; }
                __syncthreads();
                if (F.lane < it) { const int t = gw + F.lane * NGW;
                    const unsigned g1 = mp1 + LCNT[16 + me1], g2 = mp2 + LCNT[16 + me2];
                    st32(ERT + (size_t)me1 * TC + g1, (unsigned)t); st32f(ERW + (size_t)me1 * TC + g1, mw1);
                    st32(ERT + (size_t)me2 * TC + g2, (unsigned)(t | (1 << 24))); st32f(ERW + (size_t)me2 * TC + g2, mw2); }
                __syncthreads();
            }
            PH_END
            PH_BEGIN if constexpr ((PHMASK >> 9) & 1)
            { DEFPTRS DEFL
                if (F.tid == 0) { int acc = 0; _Pragma("clang loop unroll(disable)") for (int e = 0; e < 16; ++e) { const int nb = ((int)CNT[e] + 255) >> 8; OFFS[e] = acc; _Pragma("clang loop vectorize(disable) unroll(disable)") for (int q = 0; q < nb; ++q) BLKE[acc + q] = e; acc += nb; } NBR[0] = acc; }
                __syncthreads();
                pg8::Gemm g{XB1, (const bf16_t*)(wb + WB_W1), 1024, 1024, 1024}; MoeOrder S{NBR[0], 2, F.G, bx, BLKE}; EpiSwiglu E{HID};
                { const int tl = fresh(F.tid);
                  _Pragma("clang loop unroll(disable)")
                  for (int un = 0; un < 8; ++un) { const int pmu = S.row_block(un); if (pmu < 0) break;
                      if (tl < 256) { int v; float w;
                          if (pmu >= BASE_SH / 256) { v = ((pmu - BASE_SH / 256) * 256 + tl) | (2 << 24); w = 1.f; }
                          else { const int e = BLKE[pmu], pos = (pmu - OFFS[e]) * 256 + tl; const bool ok = pos < (int)CNT[e];
                                 v = ok ? ERT[(size_t)e * TC + pos] : -1; w = ok ? ERW[(size_t)e * TC + pos] : 0.f; }
                          st32(ROWTOK + pmu * 256 + tl, (unsigned)v); st32f(ROWW + pmu * 256 + tl, w); } }
                  asm volatile("s_waitcnt vmcnt(0)" ::: "memory"); }
                __syncthreads();
                pg8::gemm_phase<EpiSwiglu, MoeOrder, true>(F.lds, fresh(F.tid), g, S, E, ROWTOK);
            }
            PH_END
            PH_BEGIN if constexpr ((PHMASK >> 10) & 1)
            { DEFPTRS DEFL
                if (F.tid == 0) { int acc = 0; _Pragma("clang loop unroll(disable)") for (int e = 0; e < 16; ++e) { const int nb = ((int)CNT[e] + 255) >> 8; OFFS[e] = acc; _Pragma("clang loop vectorize(disable) unroll(disable)") for (int q = 0; q < nb; ++q) BLKE[acc + q] = e; acc += nb; } NBR[0] = acc; }
                __syncthreads();
                pg8::Gemm g{HID, (const bf16_t*)(wb + WB_W2), 256, 256, 256}; MoeOrder S{NBR[0], 4, F.G, bx, BLKE}; EpiDown E{YS, ROWTOK, ROWW};
                pg8::gemm_phase(F.lds, fresh(F.tid), g, S, E);
            }
            PH_END
            PH_BEGIN if constexpr ((PHMASK >> 11) & 1)
            { DEFPTRS DEFL
                const float* g = (const float*)ap->in[29] + l * D; const float* b = (const float*)ap->in[30] + l * D;
                f32x4 gv[4], bv[4];
#pragma unroll
                for (int j = 0; j < 4; ++j) { gv[j] = *(const f32x4*)(g + 4 * F.lane + 256 * j); bv[j] = *(const f32x4*)(b + 4 * F.lane + 256 * j); }
                u32x2 nx[4], ny[3][4];
#pragma unroll
                for (int j = 0; j < 4; ++j) { nx[j] = *((const u32x2*)(XB1 + (size_t)gw * D) + F.lane + 64 * j);
#pragma unroll
                    for (int k = 0; k < 3; ++k) ny[k][j] = *((const u32x2*)(YS + ((size_t)k * TC + gw) * D) + F.lane + 64 * j); }
                for (int t = gw; t < TC; t += NGW) {
                    f32x4 v[4]; float s = 0.f; u32x2 cx[4], cy[3][4];
#pragma unroll
                    for (int j = 0; j < 4; ++j) { cx[j] = nx[j];
#pragma unroll
                        for (int k = 0; k < 3; ++k) cy[k][j] = ny[k][j]; }
                    if (t + NGW < TC) { const size_t tn = (size_t)(t + NGW);
#pragma unroll
                        for (int j = 0; j < 4; ++j) { nx[j] = *((const u32x2*)(XB1 + tn * D) + F.lane + 64 * j);
#pragma unroll
                            for (int k = 0; k < 3; ++k) ny[k][j] = *((const u32x2*)(YS + ((size_t)k * TC + tn) * D) + F.lane + 64 * j); } }
#pragma unroll
                    for (int j = 0; j < 4; ++j) { { const u32x2 xw = cx[j]; v[j] = ALPHA * (f32x4){__uint_as_float(xw.x << 16), __uint_as_float(xw.x & 0xffff0000u), __uint_as_float(xw.y << 16), __uint_as_float(xw.y & 0xffff0000u)}; }
#pragma unroll
                        for (int k = 0; k < 3; ++k) { const u32x2 w = cy[k][j];
                            v[j][0] += __uint_as_float(w.x << 16); v[j][1] += __uint_as_float(w.x & 0xffff0000u); v[j][2] += __uint_as_float(w.y << 16); v[j][3] += __uint_as_float(w.y & 0xffff0000u); }
                        s += (v[j][0] + v[j][1]) + (v[j][2] + v[j][3]); }
                    const float mean = wave_sum(s) * (1.f / D); float s2 = 0.f;
#pragma unroll
                    for (int j = 0; j < 4; ++j) { v[j] = v[j] - mean; s2 += (v[j][0] * v[j][0] + v[j][1] * v[j][1]) + (v[j][2] * v[j][2] + v[j][3] * v[j][3]); }
                    const float rstd = 1.0f / sqrtf(wave_sum(s2) * (1.f / D) + LN_EPS);
#pragma unroll
                    for (int j = 0; j < 4; ++j) { v[j] = v[j] * rstd * gv[j] + bv[j];
                        if (l == DEPTH - 1) st128f((f32x4*)(X + (size_t)t * D) + F.lane + 64 * j, v[j]);
                        else { u32x2 w; w.x = pk2(v[j][0], v[j][1]); w.y = pk2(v[j][2], v[j][3]); st64((u32x2*)(XB + (size_t)t * D) + F.lane + 64 * j, w); } }
                }
                if (l == DEPTH - 1 && c + 1 < NCHUNK) { const int cn_ = c + 1; { const int c = cn_;
        { DEFPTRS
            const float* xin = (const float*)ap->in[0] + (size_t)T0 * D; const int* pos = (const int*)ap->in[1] + T0;
            const float* g = (const float*)ap->in[2]; const float* b = (const float*)ap->in[3];
            f32x4 gv[4], bv[4];
#pragma unroll
            for (int j = 0; j < 4; ++j) { gv[j] = *(const f32x4*)(g + 4 * F.lane + 256 * j); bv[j] = *(const f32x4*)(b + 4 * F.lane + 256 * j); }
            const float invf = F.lane < 8 ? ap->invf_p[F.lane & 7] : ap->invf_m[(F.lane - 8) & 15];
            f32x4 nv[4]; int npos = pos[gw];
#pragma unroll
            for (int j = 0; j < 4; ++j) nv[j] = ((const f32x4*)(xin + (size_t)gw * D) + F.lane)[64 * j];
            for (int t = gw; t < TC; t += NGW) {
                f32x4 v[4]; float s = 0.f; const int cpos = npos;
#pragma unroll
                for (int j = 0; j < 4; ++j) v[j] = nv[j];
                if (t + NGW < TC) { npos = pos[t + NGW];
#pragma unroll
                    for (int j = 0; j < 4; ++j) nv[j] = ((const f32x4*)(xin + (size_t)(t + NGW) * D) + F.lane)[64 * j]; }
#pragma unroll
                for (int j = 0; j < 4; ++j) s += (v[j][0] + v[j][1]) + (v[j][2] + v[j][3]);
                const float mean = wave_sum(s) * (1.f / D); float s2 = 0.f;
#pragma unroll
                for (int j = 0; j < 4; ++j) { v[j] = v[j] - mean; s2 += (v[j][0] * v[j][0] + v[j][1] * v[j][1]) + (v[j][2] * v[j][2] + v[j][3] * v[j][3]); }
                const float rstd = 1.0f / sqrtf(wave_sum(s2) * (1.f / D) + LN_EPS);
#pragma unroll
                for (int j = 0; j < 4; ++j) { v[j] = v[j] * rstd * gv[j] + bv[j];
                    u32x2 w; w.x = pk2(v[j][0], v[j][1]); w.y = pk2(v[j][2], v[j][3]); st64((u32x2*)(XB + (size_t)t * D) + F.lane + 64 * j, w); }
                if (F.lane < 24) {
                    const float ang = (float)cpos * invf;
                    const double rev = (double)ang * 0.15915494309189535; const float fr = (float)(rev - __builtin_rint(rev));
                    const float cs = __builtin_amdgcn_cosf(fr), sn = __builtin_amdgcn_sinf(fr);
                    if (F.lane < 8) { st32f(COSP + (size_t)t * 8 + F.lane, cs); st32f(SINP + (size_t)t * 8 + F.lane, sn); }
                    else { st32f(COSM + (size_t)t * 16 + F.lane - 8, cs); st32f(SINM + (size_t)t * 16 + F.lane - 8, sn); }
                }
            }
        }
                } }
            }
            PH_END
        }
    }
#undef PH_BEGIN
#undef PH_END
}

constexpr int N_PHASES = 1 + NCHUNK * (DEPTH * 9);
#ifndef MK_MULTI
#define MK_MULTI 0
#endif

extern "C" void kernel_launch(void* const* d_in, const int* in_sizes, int n_in, void* d_out, int out_size, void* d_ws, size_t ws_size, hipStream_t stream) {
    static int grid = 0;
    if (grid == 0) {
        if (n_in != 31 || out_size != TT * D || ws_size < WS_END) { fprintf(stderr, "kernel_launch: unexpected shapes: n_in %d out %d ws %zu (need %zu)\n", n_in, out_size, ws_size, (size_t)WS_END); grid = -1; return; }
        int dev = 0, cus = 0, per_cu = 0;
        if (hipGetDevice(&dev) != hipSuccess || hipDeviceGetAttribute(&cus, hipDeviceAttributeMultiprocessorCount, dev) != hipSuccess) { grid = -1; return; }
        if (hipFuncSetAttribute((const void*)fwd_kernel, hipFuncAttributeMaxDynamicSharedMemorySize, LDS_BYTES) != hipSuccess) { fprintf(stderr, "kernel_launch: hipFuncSetAttribute failed\n"); grid = -1; return; }
        if (hipOccupancyMaxActiveBlocksPerMultiprocessor(&per_cu, (const void*)fwd_kernel, NW * 64, LDS_BYTES) != hipSuccess || per_cu < 1) fprintf(stderr, "kernel_launch: occupancy query says %d\n", per_cu);
        (void)hipGetLastError();
        grid = cus;
    }
    if (grid < 0) return;
    if (hipMemsetAsync((char*)d_ws + WS_CTL, 0, CTL_ZERO_BYTES, stream) != hipSuccess) return;
    Args a; memset(&a, 0, sizeof(a));
    for (int i = 0; i < 31; ++i) a.in[i] = (GAS const void*)d_in[i];
    a.out = (GAS float*)d_out; a.ws = (GAS unsigned char*)d_ws;
    for (int i = 0; i < 8; ++i) a.invf_p[i] = (float)pow(500000.0, -(double)(2 * i) / 16.0);
    for (int i = 0; i < 16; ++i) a.invf_m[i] = (float)pow(500000.0, -(double)(2 * i) / 32.0);
    for (int l = 0; l < 2; ++l) { a.lam_init[l] = (float)(0.8 - 0.6 * exp(-0.3 * l)); a.oml[l] = 1.0f - a.lam_init[l]; }
#if MK_MULTI
    for (int p = 0; p < N_PHASES; ++p) { a.ph_lo = p; a.ph_hi = p + 1; hipLaunchKernelGGL(fwd_kernel, dim3(grid), dim3(NW * 64), LDS_BYTES, stream, a); }
#else
    a.ph_lo = 0; a.ph_hi = N_PHASES; hipLaunchKernelGGL(fwd_kernel, dim3(grid), dim3(NW * 64), LDS_BYTES, stream, a);
#endif
    const hipError_t le = hipPeekAtLastError();
    if (le != hipSuccess) fprintf(stderr, "kernel_launch: launch failed: %s\n", hipGetErrorName(le));
}
```

```cpp
#include <hip/hip_runtime.h>
#include <cstdio>
#include <cstdint>
#include <cmath>
#include <cstring>

#define LAS __attribute__((address_space(3)))
#define GAS __attribute__((address_space(1)))
typedef unsigned short bf16_t;
typedef short bf16x8 __attribute__((ext_vector_type(8)));
typedef short s16x4 __attribute__((ext_vector_type(4)));
typedef float f32x4 __attribute__((ext_vector_type(4)));
typedef float f32x2 __attribute__((ext_vector_type(2)));
typedef float f32x16 __attribute__((ext_vector_type(16)));
typedef unsigned u32x4 __attribute__((ext_vector_type(4)));
typedef unsigned u32x2 __attribute__((ext_vector_type(2)));

__device__ __forceinline__ void st128(void* p, u32x4 v) { asm volatile("global_store_dwordx4 %0, %1, off sc0 sc1\n\ts_nop 2" :: "v"((GAS void*)p), "v"(v) : "memory"); }
__device__ __forceinline__ void st128f(void* p, f32x4 v) { asm volatile("global_store_dwordx4 %0, %1, off sc0 sc1\n\ts_nop 2" :: "v"((GAS void*)p), "v"(v) : "memory"); }
__device__ __forceinline__ void st64(void* p, u32x2 v) { asm volatile("global_store_dwordx2 %0, %1, off sc0 sc1" :: "v"((GAS void*)p), "v"(v) : "memory"); }
__device__ __forceinline__ void st32(void* p, unsigned v) { asm volatile("global_store_dword %0, %1, off sc0 sc1" :: "v"((GAS void*)p), "v"(v) : "memory"); }
__device__ __forceinline__ void st32f(void* p, float v) { asm volatile("global_store_dword %0, %1, off sc0 sc1" :: "v"((GAS void*)p), "v"(v) : "memory"); }
__device__ __forceinline__ void st16(void* p, unsigned v) { asm volatile("global_store_short %0, %1, off sc0 sc1" :: "v"((GAS void*)p), "v"(v) : "memory"); }

constexpr int D = 1024, BATCH = 8, SEQ = 8192, DEPTH = 2, TT = BATCH * SEQ;
constexpr int NBC = 4;
constexpr int TC = NBC * SEQ;
constexpr int NCHUNK = BATCH / NBC;
constexpr int IN_WIDTH = 8352;
constexpr int NIN_A = 5376;
constexpr int NIN_T = 8448;
constexpr int NEXP = 16;
constexpr float LN_EPS = 1e-5f, RMS_EPS = 1e-6f;
constexpr float ALPHA = 1.4142135623730951f;
constexpr float LOG2E = 1.4426950408889634f;

namespace pg8 {
constexpr int BM = 256, BK = 64, HALF = 128, HTB = HALF * BK * 2, STAGE_BYTES = 8 * HTB;
__host__ __device__ __forceinline__ int lds_byte(int r, int c) { const int st = (r >> 4) * 2 + (c >> 5), rr = r & 15, cc = c & 31, ob = rr * 64 + cc * 2; return st * 1024 + (ob ^ (((ob >> 9) & 1) << 5)); }
__host__ __device__ __forceinline__ void stage_rc(int b, int& R, int& C) { const int st = b / 1024, sb = b % 1024, swz = sb ^ (((sb >> 9) & 1) << 5); R = (st >> 1) * 16 + swz / 64; C = (st & 1) * 32 + (swz % 64) / 2; }
__host__ __device__ __forceinline__ int perm32(int rho) { const int n = rho >> 4, i = rho & 15; return 8 * (i >> 2) + 4 * n + (i & 3); }
struct Unit { int pm, pn; };
struct Gemm { const bf16_t* A; const bf16_t* Bt; int lda, ldb, K; };

struct StaticOrder {
    int nM, nN, nwg, G, c;
    __device__ void init(int M, int N, int G_, int c_) { nM = M / BM; nN = N / BM; nwg = nM * nN; G = G_; c = c_; }
    __device__ bool next(int i, Unit& u) const {
        const long L = (long)i * G + c; if (L >= nwg) return false;
        int wgid = (int)L; { const int q = nwg / 8, r = nwg % 8, xcd = wgid % 8, off = wgid / 8; wgid = (xcd < r ? xcd * (q + 1) : r * (q + 1) + (xcd - r) * q) + off; }
        const int nig = 8 * nN, gid = wgid / nig, fm = gid * 8, gsz = (nM - fm) < 8 ? (nM - fm) : 8;
        u.pm = fm + ((wgid % nig) % gsz); u.pn = (wgid % nig) / gsz; return true;
    }
};

__device__ __forceinline__ unsigned cvt_pk_bf16(float lo, float hi) { unsigned r; asm volatile("v_cvt_pk_bf16_f32 %0, %1, %2" : "=v"(r) : "v"(lo), "v"(hi)); return r; }

template <class Epi, class Sched, bool GATHER = false>
__device__ __forceinline__ void gemm_phase(LAS unsigned char* lds, const int tid, const Gemm g, const Sched& S, const Epi& E, const int* gtab = nullptr) {
    const int wid = __builtin_amdgcn_readfirstlane(tid >> 6), lane = tid & 63, wr = wid >> 2, wc = wid & 3, fr = lane & 15, fq = lane >> 4;
    const int K = g.K, nt = K / BK;
    unsigned voffA[2], voffB[2];
#define PG8_GOFF(dst, pm_) do { const int sh_ = __builtin_ctz(g.lda * 2); _Pragma("unroll") for (int h_ = 0; h_ < 2; ++h_) _Pragma("unroll") for (int i_ = 0; i_ < 2; ++i_) { \
        const int r_ = gtab[(pm_) * 256 + h_ * 128 + (int)(voffA[i_] >> sh_)]; dst[h_][i_] = ((unsigned)(r_ < 0 ? 0 : (r_ & 0xffffff)) << sh_) + (voffA[i_] & ((1u << sh_) - 1u)); } } while (0)
#pragma unroll
    for (int i = 0; i < 2; ++i) { int R, C; stage_rc(tid * 16 + i * 8192, R, C); const int Rb = (R & ~31) + perm32(R & 31);
        voffA[i] = (unsigned)(R * g.lda + C) * 2u; voffB[i] = (unsigned)(Rb * g.ldb + C) * 2u; }
    const size_t kstep = (size_t)(BK * 2);
    const size_t hsA = (size_t)HALF * g.lda * 2, hsB = (size_t)HALF * g.ldb * 2;
    const size_t tsA = 2 * hsA, tsB = 2 * hsB;
    const unsigned ldsw = (unsigned)wid * 1024u;
    const int aoff = lds_byte(wr * 64 + fr, fq * 8), boff = lds_byte(wc * 32 + fr, fq * 8);
#define PG8_SA(b, h) (((b) * 2 + (h)) * HTB)
#define PG8_SB(b, h) ((4 + (b) * 2 + (h)) * HTB)
#define PG8_STAGE(bufoff, gbase, voff) do { _Pragma("unroll") for (int _i = 0; _i < 2; ++_i) \
        __builtin_amdgcn_global_load_lds((const unsigned*)((const char*)(gbase) + (voff)[_i]), (LAS unsigned*)(lds + (bufoff) + ldsw + _i * 8192), 16, 0, 0); } while (0)
#define PG8_STAGE_A(bufoff, base, h, GO) do { if constexpr (GATHER) PG8_STAGE(bufoff, base, GO[h]); else PG8_STAGE(bufoff, (base) + (h) * hsA, voffA); } while (0)
#define PG8_LDA(dst, b, h) do { _Pragma("unroll") for (int m = 0; m < 4; ++m) _Pragma("unroll") for (int k = 0; k < 2; ++k) dst[m][k] = *(const LAS bf16x8*)(lds + PG8_SA(b, h) + aoff + m * 2048 + k * 1024); } while (0)
#define PG8_LDB(dst, b, h) do { _Pragma("unroll") for (int n = 0; n < 2; ++n) _Pragma("unroll") for (int k = 0; k < 2; ++k) dst[n][k] = *(const LAS bf16x8*)(lds + PG8_SB(b, h) + boff + n * 2048 + k * 1024); } while (0)
#define PG8_MMA(ai, bj, At, Bt) do { __builtin_amdgcn_s_setprio(1); _Pragma("unroll") for (int m = 0; m < 4; ++m) _Pragma("unroll") for (int n = 0; n < 2; ++n) _Pragma("unroll") for (int k = 0; k < 2; ++k) \
        acc[ai][bj][m][n] = __builtin_amdgcn_mfma_f32_16x16x32_bf16(Bt[n][k], At[m][k], acc[ai][bj][m][n], 0, 0, 0); __builtin_amdgcn_s_setprio(0); } while (0)
#define PG8_WAIT_V(n) asm volatile("s_waitcnt vmcnt(" #n ")" ::: "memory")
#define PG8_WAIT_L(n) asm volatile("s_waitcnt lgkmcnt(" #n ")" ::: "memory")
#define PG8_BAR __builtin_amdgcn_s_barrier()
#define PG8_SCHED __builtin_amdgcn_sched_barrier(0)
    Unit cur, nxt; int ui = 0;
    if (!S.next(0, cur)) return;
    float zr = 0.f; asm volatile("" : "+v"(zr));
    f32x4 acc[2][2][4][2];
#pragma unroll
    for (int a = 0; a < 2; ++a)
#pragma unroll
        for (int b = 0; b < 2; ++b)
#pragma unroll
            for (int m = 0; m < 4; ++m)
#pragma unroll
                for (int n = 0; n < 2; ++n) acc[a][b][m][n] = (f32x4){zr, zr, zr, zr};
    bf16x8 At[4][2], B0[2][2], B1[2][2];
    const char* cA = GATHER ? (const char*)g.A : (const char*)g.A + (size_t)cur.pm * tsA; const char* cB = (const char*)g.Bt + (size_t)cur.pn * tsB;
    unsigned gC[2][2], gN[2][2]; if constexpr (GATHER) PG8_GOFF(gC, cur.pm);
    PG8_STAGE(PG8_SB(0, 0), cB, voffB); PG8_STAGE(PG8_SB(0, 1), cB + hsB, voffB); PG8_STAGE_A(PG8_SA(0, 0), cA, 0, gC); PG8_STAGE_A(PG8_SA(0, 1), cA, 1, gC);
    if (wr == 1) PG8_BAR;
    PG8_WAIT_V(2); PG8_BAR;
    PG8_STAGE(PG8_SB(1, 0), cB + kstep, voffB); PG8_STAGE_A(PG8_SA(1, 0), cA + kstep, 0, gC); PG8_STAGE(PG8_SB(1, 1), cB + hsB + kstep, voffB);
    PG8_WAIT_V(6); PG8_BAR;
    for (;;) {
        const bool has_next = S.next(ui + 1, nxt);
        const char* nA = GATHER ? (const char*)g.A : (has_next ? (const char*)g.A + (size_t)nxt.pm * tsA : cA); const char* nB = has_next ? (const char*)g.Bt + (size_t)nxt.pn * tsB : cB;

#pragma unroll 1
        for (int t = 0; t < nt; t += 2) {
            const bool last = (t == nt - 2);
            const char* a1 = cA + (size_t)(t + 1) * kstep;
            const char* a2 = last ? nA : cA + (size_t)(t + 2) * kstep; const char* b2 = last ? nB : cB + (size_t)(t + 2) * kstep;
            const char* a3 = a2 + kstep; const char* b3 = b2 + kstep;
            unsigned g2[2][2]; if constexpr (GATHER) { if (last && has_next) { PG8_GOFF(gN, nxt.pm); _Pragma("unroll") for (int h_ = 0; h_ < 2; ++h_) _Pragma("unroll") for (int i_ = 0; i_ < 2; ++i_) g2[h_][i_] = gN[h_][i_]; }
                else { _Pragma("unroll") for (int h_ = 0; h_ < 2; ++h_) _Pragma("unroll") for (int i_ = 0; i_ < 2; ++i_) g2[h_][i_] = gC[h_][i_]; } }
            PG8_LDB(B0, 0, 0); PG8_LDB(B1, 0, 1); PG8_SCHED; PG8_LDA(At, 0, 0); PG8_STAGE_A(PG8_SA(1, 1), a1, 1, gC);
            PG8_WAIT_V(8); PG8_WAIT_L(0); PG8_BAR; PG8_MMA(0, 0, At, B0); PG8_MMA(0, 1, At, B1); PG8_BAR; PG8_SCHED;
            PG8_LDA(At, 0, 1); PG8_STAGE(PG8_SB(0, 0), b2, voffB); PG8_STAGE(PG8_SB(0, 1), b2 + hsB, voffB); PG8_STAGE_A(PG8_SA(0, 0), a2, 0, g2);
            PG8_WAIT_V(8); PG8_WAIT_L(0); PG8_BAR; PG8_MMA(1, 0, At, B0); PG8_MMA(1, 1, At, B1); PG8_BAR; PG8_SCHED;
            PG8_LDB(B0, 1, 0); PG8_LDB(B1, 1, 1); PG8_SCHED; PG8_LDA(At, 1, 0); PG8_STAGE_A(PG8_SA(0, 1), a2, 1, g2);
            PG8_WAIT_V(8); PG8_WAIT_L(0); PG8_BAR; PG8_MMA(0, 0, At, B0); PG8_MMA(0, 1, At, B1); PG8_BAR; PG8_SCHED;
            PG8_LDA(At, 1, 1); PG8_STAGE(PG8_SB(1, 0), b3, voffB); PG8_STAGE(PG8_SB(1, 1), b3 + hsB, voffB); PG8_STAGE_A(PG8_SA(1, 0), a3, 0, g2);
            PG8_WAIT_V(8); PG8_WAIT_L(0); PG8_BAR; PG8_MMA(1, 0, At, B0); PG8_MMA(1, 1, At, B1); PG8_BAR; PG8_SCHED;
        }
        if (wr == 0) PG8_BAR;
        { int ln; asm volatile("v_mbcnt_lo_u32_b32 %0, -1, 0\n\tv_mbcnt_hi_u32_b32 %0, -1, %0" : "=v"(ln));
          E(acc, cur, wr, wc, ln & 15, ln >> 4); }
        if (!has_next) break;
        if (!E.keep(cur))
#pragma unroll
        for (int a = 0; a < 2; ++a)
#pragma unroll
            for (int b = 0; b < 2; ++b)
#pragma unroll
                for (int m = 0; m < 4; ++m)
#pragma unroll
                    for (int n = 0; n < 2; ++n) acc[a][b][m][n] = (f32x4){zr, zr, zr, zr};
        cur = nxt; cA = nA; cB = nB; ++ui;
        if constexpr (GATHER) { _Pragma("unroll") for (int h_ = 0; h_ < 2; ++h_) _Pragma("unroll") for (int i_ = 0; i_ < 2; ++i_) gC[h_][i_] = gN[h_][i_]; }

        if (wr == 1) PG8_BAR;
    }
    PG8_WAIT_V(0);
    PG8_BAR;
#undef PG8_SA
#undef PG8_SB
#undef PG8_STAGE
#undef PG8_STAGE_A
#undef PG8_GOFF
#undef PG8_LDA
#undef PG8_LDB
#undef PG8_MMA
#undef PG8_WAIT_V
#undef PG8_WAIT_L
#undef PG8_BAR
#undef PG8_SCHED
}
}

__device__ __forceinline__ float row16_sum(float v);
namespace att {
#define SBAR() __builtin_amdgcn_sched_barrier(0)
__device__ __forceinline__ int crow(int r, int hi) { return (r & 3) + 8 * (r >> 2) + 4 * hi; }
__device__ __forceinline__ unsigned cvtpk(float lo, float hi) { unsigned r; asm volatile("v_cvt_pk_bf16_f32 %0, %1, %2" : "=v"(r) : "v"(lo), "v"(hi)); return r; }
template <int DQK> __device__ __forceinline__ int kswz(int row, int colB) {
    if (DQK == 64) return row * 128 + (colB ^ (((row >> 1) & 7) << 4));
    else return row * 256 + (colB ^ ((row & 15) << 4));
}
template <int DQK> struct KCfg { static constexpr int KP = (DQK == 64) ? 128 : 256, SHM_K = 64 * KP, CPR = DQK / 8, NKC = (64 * CPR + 511) / 512, NQ = DQK / 16; };
template <int DV> struct VCfg { static constexpr int NCB = DV / 32, SHM_V = 64 * DV * 2, CPR = DV / 8, NVC = (64 * CPR) / 512; };
template <int NCB> __device__ __forceinline__ int v_st(int k, int c) { const int kk = (k & ~0xC) | ((k & 4) << 1) | ((k & 8) >> 1); return ((kk >> 3) * NCB + (c >> 5)) * 512 + ((kk & 7) * 32 + (c & 31)) * 2; }
__device__ __forceinline__ int v_rd_base(int lane) { return ((lane & 3) << 3) | (((lane >> 2) & 3) << 6) | (((lane >> 4) & 1) << 5) | (((lane >> 5) & 1) << 8); }
template <int OFF> __device__ __forceinline__ s16x4 tr_read(int vb) { s16x4 r; asm volatile("ds_read_b64_tr_b16 %0, %1 offset:%2" : "=&v"(r) : "v"(vb), "i"(OFF) : "memory"); return r; }

__device__ __forceinline__ void partialSM(f32x16& p0, f32x16& p1, float& m_reg, float& alpha, float C, float thr) {
    float pmax = p0[0];
#pragma unroll
    for (int r = 1; r < 16; ++r) pmax = fmaxf(pmax, p0[r]);
#pragma unroll
    for (int r = 0; r < 16; ++r) pmax = fmaxf(pmax, p1[r]);
    { auto rr = __builtin_amdgcn_permlane32_swap(__float_as_uint(pmax), __float_as_uint(pmax), false, false); pmax = fmaxf(__uint_as_float(rr[0]), __uint_as_float(rr[1])); }
    float mn;
    if (__builtin_expect(__all(pmax - m_reg <= thr), 1)) { mn = m_reg; alpha = 1.f; }
    else { mn = fmaxf(m_reg, pmax); alpha = __builtin_amdgcn_exp2f((m_reg - mn) * C); m_reg = mn; }
    const float mnC = -mn * C;
#pragma unroll
    for (int r = 0; r < 16; ++r) p0[r] = fmaf(p0[r], C, mnC);
#pragma unroll
    for (int r = 0; r < 16; ++r) p1[r] = fmaf(p1[r], C, mnC);
#pragma unroll
    for (int r = 0; r < 16; ++r) p0[r] = __builtin_amdgcn_exp2f(p0[r]);
}
__device__ __forceinline__ void finishSM(f32x16& p0, f32x16& p1, float alpha, float& l_reg, bf16x8& pa0, bf16x8& pa1, bf16x8& pa2, bf16x8& pa3) {
#pragma unroll
    for (int r = 0; r < 16; ++r) p1[r] = __builtin_amdgcn_exp2f(p1[r]);
    float ps = 0;
#pragma unroll
    for (int r = 0; r < 16; ++r) ps += p0[r];
#pragma unroll
    for (int r = 0; r < 16; ++r) ps += p1[r];
    { auto rr = __builtin_amdgcn_permlane32_swap(__float_as_uint(ps), __float_as_uint(ps), false, false); ps = __uint_as_float(rr[0]) + __uint_as_float(rr[1]); }
    l_reg = l_reg * alpha + ps;
#define PK4(P, BASE, OUT) do { unsigned a0 = cvtpk(P[BASE + 0], P[BASE + 1]), a1 = cvtpk(P[BASE + 2], P[BASE + 3]);   \
    unsigned b0 = cvtpk(P[BASE + 4], P[BASE + 5]), b1 = cvtpk(P[BASE + 6], P[BASE + 7]);                              \
    auto r0 = __builtin_amdgcn_permlane32_swap(a0, b0, false, false); auto r1 = __builtin_amdgcn_permlane32_swap(a1, b1, false, false); \
    u32x4 w = {r0[0], r1[0], r0[1], r1[1]}; OUT = __builtin_bit_cast(bf16x8, w); } while (0)
    PK4(p0, 0, pa0); PK4(p0, 8, pa1); PK4(p1, 0, pa2); PK4(p1, 8, pa3);
#undef PK4
}
__device__ __forceinline__ void finishSM_pack(f32x16& p0, f32x16& p1, bf16x8& pa0, bf16x8& pa1, bf16x8& pa2, bf16x8& pa3) {
#define PK4(P, BASE, OUT) do { unsigned a0 = cvtpk(P[BASE + 0], P[BASE + 1]), a1 = cvtpk(P[BASE + 2], P[BASE + 3]);   \
    unsigned b0 = cvtpk(P[BASE + 4], P[BASE + 5]), b1 = cvtpk(P[BASE + 6], P[BASE + 7]);                              \
    auto r0 = __builtin_amdgcn_permlane32_swap(a0, b0, false, false); auto r1 = __builtin_amdgcn_permlane32_swap(a1, b1, false, false); \
    u32x4 w = {r0[0], r1[0], r0[1], r1[1]}; OUT = __builtin_bit_cast(bf16x8, w); } while (0)
    PK4(p0, 0, pa0); PK4(p0, 8, pa1); PK4(p1, 0, pa2); PK4(p1, 8, pa3);
#undef PK4
}
template <int DQK> __device__ __forceinline__ void qkt(f32x16& p0, f32x16& p1, const LAS char* Ks, const bf16x8* qr, int r32, int hi) {
    p0 = f32x16{}; p1 = f32x16{};
#pragma unroll
    for (int d0 = 0; d0 < DQK / 16; ++d0) { const int cb = (d0 * 16 + hi * 8) * 2;
        const bf16x8 b0 = *(const LAS bf16x8*)(Ks + kswz<DQK>(r32, cb));
        const bf16x8 b1 = *(const LAS bf16x8*)(Ks + kswz<DQK>(32 + r32, cb));
        p0 = __builtin_amdgcn_mfma_f32_32x32x16_bf16(b0, qr[d0], p0, 0, 0, 0);
        p1 = __builtin_amdgcn_mfma_f32_32x32x16_bf16(b1, qr[d0], p1, 0, 0, 0); }
}
template <int NCB, int D0> __device__ __forceinline__ void pv_one(f32x16& od, int vb, bf16x8 pa0, bf16x8 pa1, bf16x8 pa2, bf16x8 pa3) {
#define VOFF(ks, half) (((2 * (ks) + (half)) * NCB + D0) * 512)
    s16x4 l0 = tr_read<VOFF(0, 0)>(vb), h0 = tr_read<VOFF(0, 1)>(vb), l1 = tr_read<VOFF(1, 0)>(vb), h1 = tr_read<VOFF(1, 1)>(vb);
    s16x4 l2 = tr_read<VOFF(2, 0)>(vb), h2 = tr_read<VOFF(2, 1)>(vb), l3 = tr_read<VOFF(3, 0)>(vb), h3 = tr_read<VOFF(3, 1)>(vb);
#undef VOFF
    asm volatile("s_waitcnt lgkmcnt(0)" : "+v"(l0), "+v"(h0), "+v"(l1), "+v"(h1), "+v"(l2), "+v"(h2), "+v"(l3), "+v"(h3) :: "memory");
#define PK(L, H) (bf16x8){L[0], L[1], L[2], L[3], H[0], H[1], H[2], H[3]}
    od = __builtin_amdgcn_mfma_f32_32x32x16_bf16(pa0, PK(l0, h0), od, 0, 0, 0);
    od = __builtin_amdgcn_mfma_f32_32x32x16_bf16(pa1, PK(l1, h1), od, 0, 0, 0);
    od = __builtin_amdgcn_mfma_f32_32x32x16_bf16(pa2, PK(l2, h2), od, 0, 0, 0);
    od = __builtin_amdgcn_mfma_f32_32x32x16_bf16(pa3, PK(l3, h3), od, 0, 0, 0);
#undef PK
}
template <int DV> __device__ __forceinline__ void pv_all(f32x16* o, int vb, bf16x8 pa0, bf16x8 pa1, bf16x8 pa2, bf16x8 pa3) {
    constexpr int NCB = DV / 32;
    pv_one<NCB, 0>(o[0], vb, pa0, pa1, pa2, pa3); pv_one<NCB, 1>(o[1], vb, pa0, pa1, pa2, pa3);
    if constexpr (NCB == 4) { pv_one<NCB, 2>(o[2], vb, pa0, pa1, pa2, pa3); pv_one<NCB, 3>(o[3], vb, pa0, pa1, pa2, pa3); }
}

__device__ __forceinline__ void dense_unit_dma(const bf16_t* __restrict__ Qb, int ldq, const bf16_t* __restrict__ K1, int ldk1, const bf16_t* __restrict__ Vh, int ldv,
                                               bf16_t* __restrict__ Ob, int ldo, int seq, float C, float thr, LAS char* lds, const int tid,
                                               int epi = 0, float lam = 0.f, const bf16_t* __restrict__ O1b = nullptr, int ldo1 = 0) {
    constexpr int DQK = 64, DV = 128, NQ = 4, NCB = 4, SLOT = 24576, VOFFB = 8192;
    const int wid = __builtin_amdgcn_readfirstlane(tid >> 6), lane = tid & 63, r32 = lane & 31, hi = lane >> 5;
    LAS float* al_l = (LAS float*)(lds + 3 * SLOT) + wid * 64;
    float mC = 0.f, l_reg = 0.f; f32x16 o[NCB], cinit = f32x16{}; bf16x8 qr[NQ]; const float thrC = thr * C;
    const bf16x8 ones = {0x3f80, 0x3f80, 0x3f80, 0x3f80, 0x3f80, 0x3f80, 0x3f80, 0x3f80};
#pragma unroll
    for (int i = 0; i < NCB; ++i) o[i] = f32x16{};
    { const bf16_t* Qw = Qb + (long)(wid * 32 + r32) * ldq + hi * 8;
#pragma unroll
      for (int d0 = 0; d0 < NQ; ++d0) { const u32x4 raw = *(const u32x4*)(Qw + d0 * 16); u32x4 sc;
#pragma unroll
          for (int i = 0; i < 4; ++i) sc[i] = cvtpk(__uint_as_float(raw[i] << 16) * C, __uint_as_float(raw[i] & 0xffff0000u) * C);
          qr[d0] = __builtin_bit_cast(bf16x8, sc); } }
    unsigned koff, voff0, voff1;
    { const int row = tid >> 3, ch = (tid & 7) ^ ((row >> 1) & 7); koff = (unsigned)(row * ldk1 + ch * 8) * 2u; }
    { const int p = tid, sub = p >> 5, w = p & 31, kk = (sub >> 2) * 8 + (w >> 2), k = (kk & ~0xC) | ((kk & 4) << 1) | ((kk & 8) >> 1), c = (sub & 3) * 32 + (w & 3) * 8; voff0 = (unsigned)(k * ldv + c) * 2u; }
    { const int p = 512 + tid, sub = p >> 5, w = p & 31, kk = (sub >> 2) * 8 + (w >> 2), k = (kk & ~0xC) | ((kk & 4) << 1) | ((kk & 8) >> 1), c = (sub & 3) * 32 + (w & 3) * 8; voff1 = (unsigned)(k * ldv + c) * 2u; }
    const size_t kts = (size_t)64 * ldk1 * 2, vts = (size_t)64 * ldv * 2;
    const int vb0 = (int)(unsigned)(unsigned long)lds + VOFFB + v_rd_base(lane);
    const int NT = seq / 64;
#define DMA(t, so) do { if ((t) < NT) { \
        __builtin_amdgcn_global_load_lds((const unsigned*)((const char*)K1 + (size_t)(t) * kts + koff), (LAS unsigned*)(lds + (so) + wid * 1024), 16, 0, 0); \
        __builtin_amdgcn_global_load_lds((const unsigned*)((const char*)Vh + (size_t)(t) * vts + voff0), (LAS unsigned*)(lds + (so) + VOFFB + wid * 1024), 16, 0, 0); \
        __builtin_amdgcn_global_load_lds((const unsigned*)((const char*)Vh + (size_t)(t) * vts + voff1), (LAS unsigned*)(lds + (so) + VOFFB + 8192 + wid * 1024), 16, 0, 0); } } while (0)
#define TBAR() do { asm volatile("s_waitcnt vmcnt(0)" ::: "memory"); __builtin_amdgcn_s_barrier(); asm volatile("" ::: "memory"); } while (0)
#define LSUM() do { ls = __builtin_amdgcn_mfma_f32_32x32x16_bf16(pa0, ones, ls, 0, 0, 0); ls = __builtin_amdgcn_mfma_f32_32x32x16_bf16(pa1, ones, ls, 0, 0, 0); ls = __builtin_amdgcn_mfma_f32_32x32x16_bf16(pa2, ones, ls, 0, 0, 0); ls = __builtin_amdgcn_mfma_f32_32x32x16_bf16(pa3, ones, ls, 0, 0, 0); } while (0)
    f32x16 pA0, pA1, pB0, pB1; bf16x8 pa0, pa1, pa2, pa3;
#define FINS(P0, P1) do { _Pragma("unroll") for (int r = 0; r < 16; ++r) P1[r] = __builtin_amdgcn_exp2f(P1[r]); \
        f32x2 s2_ = {P0[0], P0[1]}; _Pragma("unroll") for (int k = 1; k < 8; ++k) s2_ += (f32x2){P0[2 * k], P0[2 * k + 1]}; _Pragma("unroll") for (int k = 0; k < 8; ++k) s2_ += (f32x2){P1[2 * k], P1[2 * k + 1]}; \
        l_reg += s2_[0] + s2_[1]; finishSM_pack(P0, P1, pa0, pa1, pa2, pa3); } while (0)
#define QKC(P0, P1, so) do { _Pragma("unroll") for (int d0 = 0; d0 < NQ; ++d0) { const int cb = (d0 * 16 + hi * 8) * 2; \
        const bf16x8 b0 = *(const LAS bf16x8*)(lds + (so) + kswz<DQK>(r32, cb)), b1 = *(const LAS bf16x8*)(lds + (so) + kswz<DQK>(32 + r32, cb)); \
        if (d0 == 0) { P0 = __builtin_amdgcn_mfma_f32_32x32x16_bf16(b0, qr[0], cinit, 0, 0, 0); P1 = __builtin_amdgcn_mfma_f32_32x32x16_bf16(b1, qr[0], cinit, 0, 0, 0); } \
        else { P0 = __builtin_amdgcn_mfma_f32_32x32x16_bf16(b0, qr[d0], P0, 0, 0, 0); P1 = __builtin_amdgcn_mfma_f32_32x32x16_bf16(b1, qr[d0], P1, 0, 0, 0); } } } while (0)
#define SMAX(P0, P1, FORCE) do { float pmax = P0[0]; \
        _Pragma("unroll") for (int r = 1; r < 16; ++r) pmax = fmaxf(pmax, P0[r]); \
        _Pragma("unroll") for (int r = 0; r < 16; ++r) pmax = fmaxf(pmax, P1[r]); \
        { auto rr = __builtin_amdgcn_permlane32_swap(__float_as_uint(pmax), __float_as_uint(pmax), false, false); pmax = fmaxf(__uint_as_float(rr[0]), __uint_as_float(rr[1])); } \
        if (FORCE || !__all(pmax <= thrC)) { const float dl = FORCE ? pmax : fmaxf(pmax, 0.f); mC += dl; \
            _Pragma("unroll") for (int r = 0; r < 16; ++r) { cinit[r] = -mC; P0[r] -= dl; P1[r] -= dl; } \
            if (!FORCE) { if (hi == 0) al_l[r32] = __builtin_amdgcn_exp2f(-dl); asm volatile("s_waitcnt lgkmcnt(0)" ::: "memory"); \
                _Pragma("unroll") for (int d = 0; d < NCB; ++d) _Pragma("unroll") for (int r = 0; r < 16; ++r) o[d][r] *= al_l[crow(r, hi)]; \
                l_reg *= __builtin_amdgcn_exp2f(-dl); } } } while (0)
#define EXP0(P0) do { _Pragma("unroll") for (int r = 0; r < 16; ++r) P0[r] = __builtin_amdgcn_exp2f(P0[r]); } while (0)
    int s0 = 0, s1 = SLOT, s2 = 2 * SLOT;
    DMA(0, s0); DMA(1, s1); TBAR();
    QKC(pA0, pA1, s0); SMAX(pA0, pA1, true); EXP0(pA0);
    DMA(2, s2);
    for (int j = 0; j + 2 < NT; j += 2) {
        SBAR(); QKC(pB0, pB1, s1);
        FINS(pA0, pA1); SBAR();
        pv_all<DV>(o, vb0 + s0, pa0, pa1, pa2, pa3);  SMAX(pB0, pB1, false);
        TBAR(); DMA(j + 3, s0); EXP0(pB0);
        SBAR(); QKC(pA0, pA1, s2);
        FINS(pB0, pB1); SBAR();
        pv_all<DV>(o, vb0 + s1, pa0, pa1, pa2, pa3);  SMAX(pA0, pA1, false);
        TBAR(); DMA(j + 4, s1); EXP0(pA0);
        { const int t = s0; s0 = s2; s2 = s1; s1 = t; }
    }
    SBAR(); QKC(pB0, pB1, s1);
    FINS(pA0, pA1); SBAR();
    pv_all<DV>(o, vb0 + s0, pa0, pa1, pa2, pa3);  SMAX(pB0, pB1, false); EXP0(pB0);
    FINS(pB0, pB1); SBAR();
    pv_all<DV>(o, vb0 + s1, pa0, pa1, pa2, pa3);
#undef QKC
#undef SMAX
#undef EXP0
    { auto rr = __builtin_amdgcn_permlane32_swap(__float_as_uint(l_reg), __float_as_uint(l_reg), false, false); l_reg = __uint_as_float(rr[0]) + __uint_as_float(rr[1]); }
    if (hi == 0) al_l[r32] = l_reg; asm volatile("s_waitcnt lgkmcnt(0)" ::: "memory");
    float rli[16];
#pragma unroll
    for (int r = 0; r < 16; ++r) rli[r] = __builtin_amdgcn_rcpf(al_l[crow(r, hi)]);
    asm volatile("s_waitcnt lgkmcnt(0)" ::: "memory");
    __syncthreads();
    { LAS bf16_t* stg = (LAS bf16_t*)(lds + wid * (32 * DV * 2));
      constexpr int CPR = DV / 8;
      if (epi == 0) {
#pragma unroll
          for (int r = 0; r < 16; ++r) { const int orow = crow(r, hi);
#pragma unroll
              for (int d0 = 0; d0 < NCB; ++d0) stg[orow * DV + d0 * 32 + r32] = (bf16_t)(cvtpk(o[d0][r] * rli[r], 0.f) & 0xffffu); }
      } else {
          LAS bf16_t* st1 = (LAS bf16_t*)(lds + 65536 + wid * (32 * DV * 2));
          const bf16_t* O1w = O1b + (long)(wid * 32) * ldo1;
#pragma unroll
          for (int i = 0; i < 32 * CPR / 64; ++i) { const int id = i * 64 + lane, row = id / CPR, ch = id % CPR; *(LAS u32x4*)(st1 + row * DV + ch * 8) = *(const u32x4*)(O1w + (long)row * ldo1 + ch * 8); }
          asm volatile("s_waitcnt lgkmcnt(0)" ::: "memory");
          float ss[16];
#pragma unroll
          for (int r = 0; r < 16; ++r) { const int orow = crow(r, hi); float s = 0.f;
#pragma unroll
              for (int d0 = 0; d0 < NCB; ++d0) { const float o1 = __uint_as_float((unsigned)st1[orow * DV + d0 * 32 + r32] << 16);
                  const float o2 = __uint_as_float(cvtpk(0.f, o[d0][r] * rli[r]) & 0xffff0000u);
                  const float dv = o1 - lam * o2; o[d0][r] = dv; s += dv * dv; }
              ss[r] = s; }
#pragma unroll
          for (int r = 0; r < 16; ++r) { float s = row16_sum(ss[r]);
              { auto rr = __builtin_amdgcn_permlane16_swap(__float_as_uint(s), __float_as_uint(s), false, false); s = __uint_as_float(rr[0]) + __uint_as_float(rr[1]); }
              ss[r] = 1.0f / sqrtf(s * (1.f / 128.f) + RMS_EPS); }
#pragma unroll
          for (int r = 0; r < 16; ++r) { const int orow = crow(r, hi);
#pragma unroll
              for (int d0 = 0; d0 < NCB; ++d0) stg[orow * DV + d0 * 32 + r32] = (bf16_t)(cvtpk(o[d0][r] * ss[r], 0.f) & 0xffffu); }
      }
      asm volatile("s_waitcnt lgkmcnt(0)" ::: "memory");
      bf16_t* Ow = Ob + (long)(wid * 32) * ldo;
#pragma unroll
      for (int i = 0; i < 32 * CPR / 64; ++i) { const int id = i * 64 + lane, row = id / CPR, ch = id % CPR;
          st128(Ow + (long)row * ldo + ch * 8, *(const LAS u32x4*)(stg + row * DV + ch * 8)); }
      if (epi == 0) asm volatile("s_waitcnt vmcnt(0)" ::: "memory");
    }
    __syncthreads();
#undef DMA
#undef TBAR
#undef LSUM
#undef FINS
}


__device__ __forceinline__ void dense_unit64_hp(const bf16_t* __restrict__ Qb, int ldq, const bf16_t* __restrict__ K1, int ldk1, const bf16_t* __restrict__ K2, int ldk2,
                                                 const bf16_t* __restrict__ Vh, int ldv, bf16_t* __restrict__ Ob, int ldo, int seq, float C, float thr, LAS char* lds, const int tid) {
    constexpr int DQK = 96, DV = 64, NQ = 6, NQR = 6, NCB = 2, SLOT = 24576, VOFFB = 16384;
    const int wid = __builtin_amdgcn_readfirstlane(tid >> 6), lane = tid & 63, r32 = lane & 31, hi = lane >> 5;
    LAS float* wsf = (LAS float*)(lds + 3 * SLOT) + wid * 128;
    float mCA = 0.f, mCB = 0.f, lA = 0.f, lB = 0.f; f32x16 oA[2], oB[2]; bf16x8 qa[NQR]; unsigned qeA = 0u, qeB = 0u;
    LAS char* qparkA = nullptr;
    LAS char* qpark = lds + 3 * SLOT + 4096 + wid * (NQ * 1024) + lane * 16;
    const float thrC = thr * C;
    const bf16x8 ones = {0x3f80, 0x3f80, 0x3f80, 0x3f80, 0x3f80, 0x3f80, 0x3f80, 0x3f80};
    oA[0] = f32x16{}; oA[1] = f32x16{}; oB[0] = f32x16{}; oB[1] = f32x16{};
    { const bf16_t* Qw = Qb + (long)(wid * 64 + r32) * ldq + hi * 8;
#pragma unroll
      for (int d0 = 0; d0 < NQ; ++d0) { const u32x4 ra = *(const u32x4*)(Qw + d0 * 16), rb = *(const u32x4*)(Qw + 32L * ldq + d0 * 16); u32x4 sa, sb;
#pragma unroll
          for (int i = 0; i < 4; ++i) { sa[i] = cvtpk(__uint_as_float(ra[i] << 16) * C, __uint_as_float(ra[i] & 0xffff0000u) * C); sb[i] = cvtpk(__uint_as_float(rb[i] << 16) * C, __uint_as_float(rb[i] & 0xffff0000u) * C); }
          if (d0 < NQR) qa[d0] = __builtin_bit_cast(bf16x8, sa); else *(LAS u32x4*)(qparkA + (d0 - NQR) * 1024) = sa; *(LAS u32x4*)(qpark + d0 * 1024) = sb; } }
    const char* kbase = (const char*)K1 < (const char*)K2 ? (const char*)K1 : (const char*)K2;
    unsigned koff0, kst, voff;
    { const int row = tid >> 4, ch = (tid & 15) ^ (row & 15);
      if (ch >= 8 && ch < 12) { koff0 = (unsigned)((const char*)K2 - kbase) + (unsigned)(row * ldk2 + (ch - 8) * 8) * 2u; kst = (unsigned)(64 * ldk2) * 2u; }
      else { koff0 = (unsigned)((const char*)K1 - kbase) + (unsigned)(row * ldk1 + (ch & 7) * 8) * 2u; kst = (unsigned)(64 * ldk1) * 2u; } }
    { const int p = tid, sub = p >> 5, w = p & 31, kk = (sub >> 1) * 8 + (w >> 2), k = (kk & ~0xC) | ((kk & 4) << 1) | ((kk & 8) >> 1), c = (sub & 1) * 32 + (w & 3) * 8; voff = (unsigned)(k * ldv + c) * 2u; }
    const size_t vts = (size_t)64 * ldv * 2;
    const int vb0 = (int)(unsigned)(unsigned long)lds + VOFFB + v_rd_base(lane);
    const int NT = seq / 64;
#define DMA(t, so) do { if ((t) < NT) { \
        __builtin_amdgcn_global_load_lds((const unsigned*)(kbase + koff0), (LAS unsigned*)(lds + (so) + wid * 1024), 16, 0, 0); \
        __builtin_amdgcn_global_load_lds((const unsigned*)(kbase + (koff0 + (kst >> 1))), (LAS unsigned*)(lds + (so) + 8192 + wid * 1024), 16, 0, 0); \
        __builtin_amdgcn_global_load_lds((const unsigned*)((const char*)Vh + (size_t)(t) * vts + voff), (LAS unsigned*)(lds + (so) + VOFFB + wid * 1024), 16, 0, 0); \
        koff0 += kst; } } while (0)
#define TBAR() do { asm volatile("s_waitcnt vmcnt(0)" ::: "memory"); __builtin_amdgcn_s_barrier(); asm volatile("" ::: "memory"); } while (0)
    int s0 = 0, s1 = SLOT, s2 = 2 * SLOT;
    f32x16 a0, a1, b0, b1, cA = f32x16{}, cB = f32x16{};
#define QKH(P0, P1, CI, QF, so) do { const LAS char* Ks = lds + (so); \
        _Pragma("unroll") for (int d0 = 0; d0 < NQ; ++d0) { const int cb = (d0 * 16 + hi * 8) * 2; \
            const bf16x8 k0 = *(const LAS bf16x8*)(Ks + kswz<DQK>(r32, cb)), k1 = *(const LAS bf16x8*)(Ks + kswz<DQK>(32 + r32, cb)); const bf16x8 qf_ = QF(d0); \
            if (d0 == 0) { P0 = __builtin_amdgcn_mfma_f32_32x32x16_bf16(k0, qf_, CI, 0, 0, 0); P1 = __builtin_amdgcn_mfma_f32_32x32x16_bf16(k1, qf_, CI, 0, 0, 0); } \
            else { P0 = __builtin_amdgcn_mfma_f32_32x32x16_bf16(k0, qf_, P0, 0, 0, 0); P1 = __builtin_amdgcn_mfma_f32_32x32x16_bf16(k1, qf_, P1, 0, 0, 0); } } } while (0)
#define QFA(d0) qa[d0]
#define QFB(d0) (*(const LAS bf16x8*)(qpark + (d0) * 1024))
#define EXPSUM(P0, P1, PS) do { _Pragma("unroll") for (int r = 0; r < 16; ++r) { P0[r] = __builtin_amdgcn_exp2f(P0[r]); P1[r] = __builtin_amdgcn_exp2f(P1[r]); } \
        f32x2 s2_ = {P0[0], P0[1]}; _Pragma("unroll") for (int k = 1; k < 8; ++k) s2_ += (f32x2){P0[2 * k], P0[2 * k + 1]}; _Pragma("unroll") for (int k = 0; k < 8; ++k) s2_ += (f32x2){P1[2 * k], P1[2 * k + 1]}; \
        PS = s2_[0] + s2_[1]; } while (0)
#define RARE(P0, P1, PS, MC, CI, QF, L, O, WOFF, so) do { asm volatile("" ::: "memory"); QKH(P0, P1, CI, QF, so); \
        float pm_ = P0[0]; _Pragma("unroll") for (int r = 1; r < 16; ++r) pm_ = fmaxf(pm_, P0[r]); _Pragma("unroll") for (int r = 0; r < 16; ++r) pm_ = fmaxf(pm_, P1[r]); \
        { auto rr = __builtin_amdgcn_permlane32_swap(__float_as_uint(pm_), __float_as_uint(pm_), false, false); pm_ = fmaxf(__uint_as_float(rr[0]), __uint_as_float(rr[1])); } \
        const float d_ = (j == 0 ? pm_ : fmaxf(pm_, 0.f)); MC += d_; \
        int lr; asm volatile("v_mbcnt_lo_u32_b32 %0, -1, 0\n\tv_mbcnt_hi_u32_b32 %0, -1, %0" : "=v"(lr)); const int r32r = lr & 31, hir = lr >> 5; \
        _Pragma("unroll") for (int r = 0; r < 16; ++r) { CI[r] = -MC; P0[r] -= d_; P1[r] -= d_; } \
        const float al_ = __builtin_amdgcn_exp2f(-d_); L *= al_; \
        if (hir == 0) wsf[WOFF + r32r] = al_; asm volatile("s_waitcnt lgkmcnt(0)" ::: "memory"); \
        _Pragma("unroll") for (int d = 0; d < 2; ++d) _Pragma("unroll") for (int r = 0; r < 16; ++r) O[d][r] *= wsf[WOFF + crow(r, hir)]; \
        EXPSUM(P0, P1, PS); } while (0)
#define PVH(O, Q0, Q1, Q2, Q3, so) do { const int vb = vb0 + (so); pv_one<NCB, 0>(O[0], vb, Q0, Q1, Q2, Q3); pv_one<NCB, 1>(O[1], vb, Q0, Q1, Q2, Q3); } while (0)
    DMA(0, s0); DMA(1, s1); TBAR();
    QKH(a0, a1, cA, QFA, s0);
    for (int j = 0; j < NT; ++j) {
        DMA(j + 2, s2);
        bf16x8 pa0, pa1, pa2, pa3, pb0, pb1, pb2, pb3; float psA, psB;
        const float lim = j == 0 ? -1.f : 65536.f;
        QKH(b0, b1, cB, QFB, s0);
        EXPSUM(a0, a1, psA);
        if (__any(!(psA <= lim))) RARE(a0, a1, psA, mCA, cA, QFA, lA, oA, 64, s0);
        lA += psA; finishSM_pack(a0, a1, pa0, pa1, pa2, pa3);
        QKH(a0, a1, cA, QFA, s1);
        PVH(oA, pa0, pa1, pa2, pa3, s0);
        EXPSUM(b0, b1, psB);
        if (__any(!(psB <= lim))) RARE(b0, b1, psB, mCB, cB, QFB, lB, oB, 96, s0);
        lB += psB; finishSM_pack(b0, b1, pb0, pb1, pb2, pb3);
        PVH(oB, pb0, pb1, pb2, pb3, s0);
        TBAR();
        { const int t = s0; s0 = s1; s1 = s2; s2 = t; }
    }
    int lanee; asm volatile("v_mbcnt_lo_u32_b32 %0, -1, 0\n\tv_mbcnt_hi_u32_b32 %0, -1, %0" : "=v"(lanee)); const int r32e = lanee & 31, hie = lanee >> 5;
    { auto rr = __builtin_amdgcn_permlane32_swap(__float_as_uint(lA), __float_as_uint(lA), false, false); lA = __uint_as_float(rr[0]) + __uint_as_float(rr[1]); }
    { auto rr = __builtin_amdgcn_permlane32_swap(__float_as_uint(lB), __float_as_uint(lB), false, false); lB = __uint_as_float(rr[0]) + __uint_as_float(rr[1]); }
    if (hie == 0) { wsf[r32e] = lA; wsf[32 + r32e] = lB; } asm volatile("s_waitcnt lgkmcnt(0)" ::: "memory");
    float rlA[16], rlB[16];
#pragma unroll
    for (int r = 0; r < 16; ++r) { rlA[r] = __builtin_amdgcn_rcpf(wsf[crow(r, hie)]); rlB[r] = __builtin_amdgcn_rcpf(wsf[32 + crow(r, hie)]); }
    asm volatile("s_waitcnt lgkmcnt(0)" ::: "memory");
    __syncthreads();
    { LAS bf16_t* stg = (LAS bf16_t*)(lds + wid * (64 * DV * 2));
#pragma unroll
      for (int r = 0; r < 16; ++r) { const int orow = crow(r, hie);
#pragma unroll
          for (int d0 = 0; d0 < NCB; ++d0) { stg[orow * DV + d0 * 32 + r32e] = (bf16_t)(cvtpk(oA[d0][r] * rlA[r], 0.f) & 0xffffu); stg[(32 + orow) * DV + d0 * 32 + r32e] = (bf16_t)(cvtpk(oB[d0][r] * rlB[r], 0.f) & 0xffffu); } }
      asm volatile("s_waitcnt lgkmcnt(0)" ::: "memory");
      bf16_t* Ow = Ob + (long)(wid * 64) * ldo; constexpr int CPR = DV / 8;
#pragma unroll
      for (int i = 0; i < 64 * CPR / 64; ++i) { const int id = i * 64 + lanee, row = id / CPR, ch = id % CPR;
          st128(Ow + (long)row * ldo + ch * 8, *(const LAS u32x4*)(stg + row * DV + ch * 8)); } }
    __syncthreads();
#undef DMA
#undef TBAR
#undef QKH
#undef EXPSUM
#undef RARE
#undef PVH
}


__device__ __forceinline__ void band_unit(const bf16_t* __restrict__ Qh, int ldq, const bf16_t* __restrict__ Kh, int ldk, const bf16_t* __restrict__ Vh, int ldv,
                                          bf16_t* __restrict__ Oh, int ldo, float* __restrict__ lse, int ldl, int dil, int L, int j0, float C, float scale, LAS char* lds, const int tid) {
    constexpr int DQK = 64, DV = 128, NCB = 4, NQ = 4;
    const int wid = __builtin_amdgcn_readfirstlane(tid >> 6), lane = tid & 63, r32 = lane & 31, hi = lane >> 5;
    LAS char* V_lds = lds; LAS char* K_lds = lds + 16384;
    LAS float* wsf = (LAS float*)(lds + 16384 + 8192) + wid * 64; LAS float* li_l = wsf; LAS float* al_l = wsf + 32;
    float m_reg = -1e30f, l_reg = 0.f; f32x16 o[NCB]; bf16x8 qr[NQ];
#pragma unroll
    for (int i = 0; i < NCB; ++i) o[i] = f32x16{};
    const int jq = j0 + wid * 32 + r32;
    const int wlo = jq - 64 < 0 ? 0 : jq - 64, whi = jq + 64 > L - 1 ? L - 1 : jq + 64;
    { const bf16_t* Qw = Qh + (long)jq * dil * ldq + hi * 8;
#pragma unroll
      for (int d0 = 0; d0 < NQ; ++d0) qr[d0] = *(const bf16x8*)(Qw + d0 * 16); }
    const int krow = tid >> 3, kch = tid & 7, kdst = kswz<64>(krow, kch * 16);
    const int vb0 = (int)(unsigned)(unsigned long)V_lds + v_rd_base(lane);
    const int mlo = wid >> 1;
    bf16x8 kv, vv[2];
#define BLOAD(k) do { int jk = j0 - 64 + 64 * (k) + krow; jk = jk < 0 ? 0 : (jk >= L ? L - 1 : jk); kv = *(const bf16x8*)(Kh + (long)jk * dil * ldk + kch * 8); \
        _Pragma("unroll") for (int i = 0; i < 2; ++i) { const int id = tid + 512 * i, row = id >> 4, c = (id & 15) * 8; int jv = j0 - 64 + 64 * (k) + row; jv = jv < 0 ? 0 : (jv >= L ? L - 1 : jv); \
            vv[i] = *(const bf16x8*)(Vh + (long)jv * dil * ldv + c); } } while (0)
    BLOAD(0);
    for (int k = 0; k < 6; ++k) {
        { *(LAS bf16x8*)(K_lds + kdst) = kv;
#pragma unroll
          for (int i = 0; i < 2; ++i) { const int id = tid + 512 * i, row = id >> 4, c = (id & 15) * 8; *(LAS bf16x8*)(V_lds + v_st<NCB>(row, c)) = vv[i]; } }
        if (k + 1 < 6) BLOAD(k + 1);
        __syncthreads();
        if (k >= mlo && k <= mlo + 2) {
            f32x16 p0, p1; qkt<64>(p0, p1, K_lds, qr, r32, hi);
            const int jb = j0 - 64 + 64 * k;
            if (!__all(jb >= wlo && jb + 63 <= whi)) { const int db = jb - wlo + 4 * hi; const unsigned span = (unsigned)(whi - wlo);
#pragma unroll
                for (int r = 0; r < 16; ++r) { const unsigned d1 = (unsigned)(db + (r & 3) + 8 * (r >> 2));
                    p0[r] = d1 <= span ? p0[r] : -INFINITY; p1[r] = d1 + 32u <= span ? p1[r] : -INFINITY; } }
            float alpha; partialSM(p0, p1, m_reg, alpha, C, 0.f);
            if (k > mlo && __any(alpha < 1.f)) { if (hi == 0) al_l[r32] = alpha; asm volatile("s_waitcnt lgkmcnt(0)" ::: "memory");
#pragma unroll
                for (int d = 0; d < NCB; ++d)
#pragma unroll
                    for (int r = 0; r < 16; ++r) o[d][r] *= al_l[crow(r, hi)]; }
            bf16x8 pa0, pa1, pa2, pa3; finishSM(p0, p1, alpha, l_reg, pa0, pa1, pa2, pa3); SBAR();
            pv_all<DV>(o, vb0, pa0, pa1, pa2, pa3);
        }
        __syncthreads();
    }
    if (hi == 0) { li_l[r32] = l_reg; st32f(lse + (long)jq * dil * ldl, m_reg * scale + __logf(l_reg)); }
    asm volatile("s_waitcnt lgkmcnt(0)" ::: "memory");
    { LAS bf16_t* stg = (LAS bf16_t*)(lds + 32768 + wid * 8192);
#pragma unroll
      for (int r = 0; r < 16; ++r) { const int orow = crow(r, hi); const float rl = __builtin_amdgcn_rcpf(li_l[orow]);
#pragma unroll
          for (int d0 = 0; d0 < NCB; ++d0) stg[orow * DV + d0 * 32 + r32] = (bf16_t)(cvtpk(o[d0][r] * rl, 0.f) & 0xffffu); }
      asm volatile("s_waitcnt lgkmcnt(0)" ::: "memory");
#pragma unroll
      for (int i = 0; i < 8; ++i) { const int id = i * 64 + lane, row = id >> 4, ch = id & 15; const long tok = (long)(j0 + wid * 32 + row) * dil;
          st128(Oh + tok * ldo + ch * 8, *(const LAS u32x4*)(stg + row * DV + ch * 8)); } }
    __syncthreads();
}
#undef BLOAD
#undef RESC
#undef SBAR
}

constexpr size_t MiB = 1u << 20;
constexpr size_t WS_CTL = 0, CTL_ZERO_BYTES = 1 * MiB;
constexpr size_t WB_IN = 0, WB_QB = WB_IN + (size_t)NIN_T * 1024 * 2, WB_KVB = WB_QB + (size_t)768 * 384 * 2, WB_BR = WB_KVB + (size_t)1024 * 256 * 2,
                 WB_OUT = WB_BR + (size_t)3 * 1024 * 512 * 2, WB_W1 = WB_OUT + (size_t)1024 * 1024 * 2, WB_W2 = WB_W1 + (size_t)17 * 512 * 1024 * 2,
                 WB_LAYER = WB_W2 + (size_t)17 * 1024 * 256 * 2;
constexpr size_t WS_W = 1 * MiB;
constexpr size_t WS_CH = ((WS_W + DEPTH * WB_LAYER + 255) / 256) * 256;
constexpr size_t TCB = (size_t)TC;
constexpr size_t R_XB = WS_CH;
constexpr size_t R_RP = R_XB + TCB * 2048;
constexpr size_t R_A = R_RP + TCB * 192;
constexpr size_t R_B = R_A + TCB * 3072;
constexpr size_t R_C = R_B + TCB * 1536;
constexpr size_t R_O = R_C + TCB * 6144;
constexpr size_t R_M = R_O + TCB * 5248;
constexpr size_t R_T = R_M + TCB * 3584;
constexpr int BASE_SH = 2 * TC + 4096;
constexpr int NROWS = 3 * TC + 4096;
constexpr size_t R_S = ((R_T + TCB * 24 + (size_t)NROWS * 8 + 255) / 256) * 256;
constexpr size_t WS_END = R_S + TCB * 3072;
static_assert((size_t)NROWS * 2048 <= TCB * (5248 + 3584), "XG fits R_O + R_M");
static_assert((size_t)NROWS * 512 <= TCB * 3072, "HID fits R_A");
constexpr int CW_BAR = 4096;
constexpr int CW_CNT = 16384;
constexpr int RING_BYTES = 131072, MISC_OFF = RING_BYTES, LDS_BYTES = 147456;

#define XB_TMO      128
#define XB_XCNT(j)  (256  + 64 * (j))
#define XB_XSUB(j)  (1280 + 64 * (j))
#define XB_XGEN(j)  (2304 + 64 * (j))
#define XB_TOP      3328
#define XB_TOPGEN   3392
#define XCD_BAR_WORDS 3456
#define XB_SPIN_CAP (1u << 22)
__device__ __forceinline__ unsigned xb_ld(unsigned* p)              { return __hip_atomic_load(p, __ATOMIC_RELAXED, __HIP_MEMORY_SCOPE_AGENT); }
__device__ __forceinline__ unsigned xb_add(unsigned* p, unsigned v) { return __hip_atomic_fetch_add(p, v, __ATOMIC_RELAXED, __HIP_MEMORY_SCOPE_AGENT); }
__device__ __forceinline__ unsigned xb_xcc_id() { return (unsigned)__builtin_amdgcn_s_getreg((3 << 11) | 20) & 0xFu; }
#define XB_SPIN(cond, bar) do { unsigned _sp = 0; while (cond) { __builtin_amdgcn_s_sleep(1); \
    if ((++_sp & 255u) == 0u) { if (xb_ld(&(bar)[XB_TMO])) break; if (_sp > XB_SPIN_CAP) { atomicAdd(&(bar)[XB_TMO], 1u); break; } } } } while (0)
struct XcdBarrier { unsigned* bar; unsigned x; volatile LAS unsigned* st; };
__device__ __forceinline__ XcdBarrier xcd_barrier_post(unsigned* bar, volatile LAS unsigned* st) {
    XcdBarrier b; b.bar = bar; b.x = xb_xcc_id(); b.st = st;
    if (threadIdx.x == 0) (void)xb_add(&bar[XB_XCNT(b.x)], 1u);
    return b;
}
__device__ __forceinline__ void xcd_barrier_complete(unsigned* bar, unsigned x, unsigned& nloc, unsigned& nx) {
    const unsigned G = gridDim.x * gridDim.y * gridDim.z;
    unsigned sum, cnt, mine, sp = 0u;
    for (;;) {
        sum = 0u; cnt = 0u; mine = 0u;
#pragma unroll
        for (unsigned j = 0; j < 16; ++j) { const unsigned c = xb_ld(&bar[XB_XCNT(j)]); sum += c; cnt += (c > 0u) ? 1u : 0u; mine = (j == x) ? c : mine; }
        if (sum == G) break;
        __builtin_amdgcn_s_sleep(1);
        if ((++sp & 255u) == 0u) { if (xb_ld(&bar[XB_TMO])) break; if (sp > XB_SPIN_CAP) { atomicAdd(&bar[XB_TMO], 1u); break; } }
    }
    nloc = mine > 0u ? mine : 1u; nx = cnt > 0u ? cnt : 1u;
}
__device__ __forceinline__ void xcd_barrier(const XcdBarrier& b) {
    asm volatile("s_waitcnt vmcnt(0)" ::: "memory");
    __syncthreads();
    if (threadIdx.x == 0) {
        unsigned* bar = b.bar;
        __builtin_amdgcn_s_waitcnt(0);
        unsigned nloc = b.st[0], nx = b.st[1];
        if (nloc == 0u) { xcd_barrier_complete(bar, b.x, nloc, nx); b.st[0] = nloc; b.st[1] = nx; }
        const unsigned old = xb_add(&bar[XB_XSUB(b.x)], 1u);
        const unsigned gen = old / nloc;
        if (old + 1u == (gen + 1u) * nloc) {
            __builtin_amdgcn_fence(__ATOMIC_RELEASE, "agent");
            asm volatile("s_waitcnt vmcnt(0)" ::: "memory");
            const unsigned og = xb_add(&bar[XB_TOP], 1u);
            const unsigned tg = og / nx;
            if (og + 1u == (tg + 1u) * nx) xb_add(&bar[XB_TOPGEN], 1u);
            else XB_SPIN(xb_ld(&bar[XB_TOPGEN]) == tg, bar);
            __builtin_amdgcn_fence(__ATOMIC_ACQUIRE, "agent");
            xb_add(&bar[XB_XGEN(b.x)], 1u);
            asm volatile("s_waitcnt vmcnt(0)" ::: "memory");
        } else {
            XB_SPIN(xb_ld(&bar[XB_XGEN(b.x)]) == gen, bar);
            __builtin_amdgcn_fence(__ATOMIC_ACQUIRE, "agent");
            asm volatile("s_waitcnt vmcnt(0)" ::: "memory");
        }
    }
    __syncthreads();
}

template <int CTRL> __device__ __forceinline__ float dppf(float v) { return __int_as_float(__builtin_amdgcn_update_dpp(0, __float_as_int(v), CTRL, 0xF, 0xF, true)); }
__device__ __forceinline__ float row16_sum(float v) { v += dppf<0xB1>(v); v += dppf<0x4E>(v); v += dppf<0x141>(v); v += dppf<0x140>(v); return v; }
__device__ __forceinline__ float wave_sum(float v) {
    v = row16_sum(v);
    { auto rr = __builtin_amdgcn_permlane16_swap(__float_as_uint(v), __float_as_uint(v), false, false); v = __uint_as_float(rr[0]) + __uint_as_float(rr[1]); }
    { auto rr = __builtin_amdgcn_permlane32_swap(__float_as_uint(v), __float_as_uint(v), false, false); v = __uint_as_float(rr[0]) + __uint_as_float(rr[1]); }
    return v;
}
__device__ __forceinline__ unsigned pk2(float lo, float hi) { return pg8::cvt_pk_bf16(lo, hi); }
__device__ __forceinline__ float bf2f(unsigned short h) { return __uint_as_float((unsigned)h << 16); }
__device__ __forceinline__ u32x4 pack8(const f32x4 a, const f32x4 b) { u32x4 w; w.x = pk2(a[0], a[1]); w.y = pk2(a[2], a[3]); w.z = pk2(b[0], b[1]); w.w = pk2(b[2], b[3]); return w; }
__device__ __forceinline__ void unpack8(const u32x4 w, f32x4& a, f32x4& b) {
    a[0] = __uint_as_float(w.x << 16); a[1] = __uint_as_float(w.x & 0xffff0000u); a[2] = __uint_as_float(w.y << 16); a[3] = __uint_as_float(w.y & 0xffff0000u);
    b[0] = __uint_as_float(w.z << 16); b[1] = __uint_as_float(w.z & 0xffff0000u); b[2] = __uint_as_float(w.w << 16); b[3] = __uint_as_float(w.w & 0xffff0000u);
}
__device__ __forceinline__ float xor32f(float v, bool up) { auto rr = __builtin_amdgcn_permlane32_swap(__float_as_uint(v), __float_as_uint(v), false, false); return __uint_as_float(up ? rr[0] : rr[1]); }
__device__ __forceinline__ float xor16f(float v, bool odd) { auto rr = __builtin_amdgcn_permlane16_swap(__float_as_uint(v), __float_as_uint(v), false, false); return __uint_as_float(odd ? rr[0] : rr[1]); }
template <int MASK> __device__ __forceinline__ f32x4 shfl4(const f32x4 v, int fq) { f32x4 r;
#pragma unroll
    for (int j = 0; j < 4; ++j) r[j] = (MASK == 16) ? xor16f(v[j], (fq & 1) != 0) : xor32f(v[j], (fq & 2) != 0);
    return r; }
__device__ __forceinline__ int fresh(int v) { asm volatile("" : "+v"(v)); return v; }
__device__ __forceinline__ int new_tid(int wave0) { int l; asm volatile("v_mbcnt_lo_u32_b32 %0, -1, 0\n\tv_mbcnt_hi_u32_b32 %0, -1, %0" : "=v"(l)); return wave0 * 64 + l; }
__device__ __forceinline__ float sigmoidf_(float x) { return __builtin_amdgcn_rcpf(1.f + __builtin_amdgcn_exp2f(-x * LOG2E)); }

using pg8::Unit;
typedef f32x4 Acc[2][2][4][2];

struct EpiIn {
    __device__ __forceinline__ bool keep(const Unit&) const { return false; }
    GAS unsigned char* wsb;
    template <bool ROPE> __device__ __forceinline__ void store_tile(const Acc& acc, bf16_t* dst, int ld, int colt, int row0, int wc, int fq, const float* COSP, const float* SINP) const {
        const bool dorope = ROPE && ((wc & 1) == 0);
#pragma unroll
        for (int h2 = 0; h2 < 2; ++h2) {
            f32x4 c0[4], c1[4], s0[4], s1[4];
            if (dorope) {
#pragma unroll
                for (int q = 0; q < 4; ++q) { const int i = h2 * 4 + q; const size_t ro = (size_t)(row0 + (i >> 2) * 128 + (i & 3) * 16) * 8;
                    c0[q] = *(const f32x4*)(COSP + ro); c1[q] = *(const f32x4*)(COSP + ro + 4); s0[q] = *(const f32x4*)(SINP + ro); s1[q] = *(const f32x4*)(SINP + ro + 4); } }
#pragma unroll
            for (int q = 0; q < 4; ++q) { const int i = h2 * 4 + q, ai = i >> 2, m = i & 3; const int row = row0 + ai * 128 + m * 16;
                if (dorope && fq == 0) { s0[q] = -s0[q]; s1[q] = -s1[q]; }
#pragma unroll
                for (int bj = 0; bj < 2; ++bj) { f32x4 v0 = acc[ai][bj][m][0], v1 = acc[ai][bj][m][1];
                    if (dorope) { const f32x4 p0 = shfl4<16>(v0, fq), p1 = shfl4<16>(v1, fq);
                        if (fq < 2) { v0 = v0 * c0[q] + p0 * s0[q]; v1 = v1 * c1[q] + p1 * s1[q]; } }
                    st128(dst + (size_t)row * ld + colt + bj * 128 + wc * 32 + 8 * fq, pack8(v0, v1)); } }
            asm volatile("" ::: "memory"); }
    }
    __device__ __forceinline__ void operator()(const Acc& acc, const Unit& u, int wr, int wc, int fr, int fq) const {
        const int pn = u.pn, row0 = u.pm * 256 + wr * 64 + fr;
        GAS unsigned char* ws = wsb; asm volatile("" : "+s"(ws));
        const float* COSP = (const float*)(ws + R_RP); const float* SINP = COSP + TCB * 8; const float* COSM = SINP + TCB * 8; const float* SINM = COSM + TCB * 16;
        bf16_t* AQ = (bf16_t*)(ws + R_A); bf16_t* AK = AQ + TCB * 512; bf16_t* AV = AK + TCB * 512;
        bf16_t* BCQ = (bf16_t*)(ws + R_B); bf16_t* BCKV = BCQ + TCB * 384; bf16_t* MKR = BCKV + TCB * 256; float* SSQ = (float*)(MKR + TCB * 32); float* SSK = SSQ + TCB * 8;
        bf16_t* CQ = (bf16_t*)(ws + R_C); bf16_t* CK = CQ + TCB * 768; bf16_t* CV = CK + TCB * 768;
        if (pn < 2) store_tile<true>(acc, AQ, 512, pn * 256, row0, wc, fq, COSP, SINP);
        else if (pn < 4) store_tile<true>(acc, AK, 512, (pn - 2) * 256, row0, wc, fq, COSP, SINP);
        else if (pn < 6) store_tile<false>(acc, AV, 512, (pn - 4) * 256, row0, wc, fq, COSP, SINP);
        else if (pn == 6 || pn == 8) {
            bf16_t* dst = pn == 6 ? BCQ : BCKV; const int ld = pn == 6 ? 384 : 256; float* ss = pn == 6 ? SSQ : SSK; const int sld = pn == 6 ? 8 : 4;
#pragma unroll
            for (int ai = 0; ai < 2; ++ai)
#pragma unroll
                for (int m = 0; m < 4; ++m) { const int row = row0 + ai * 128 + m * 16; float s = 0.f;
#pragma unroll
                    for (int bj = 0; bj < 2; ++bj) { const f32x4 v0 = acc[ai][bj][m][0], v1 = acc[ai][bj][m][1];
                        s += (v0[0] * v0[0] + v0[1] * v0[1]) + (v0[2] * v0[2] + v0[3] * v0[3]) + (v1[0] * v1[0] + v1[1] * v1[1]) + (v1[2] * v1[2] + v1[3] * v1[3]);
                        st128(dst + (size_t)row * ld + bj * 128 + wc * 32 + 8 * fq, pack8(v0, v1)); }
                    s += xor16f(s, (fq & 1) != 0); s += xor32f(s, (fq & 2) != 0);
                    if (fq == 0) st32f(ss + (size_t)row * sld + wc, s); asm volatile("" ::: "memory"); }
        } else if (pn == 7) {
#pragma unroll
            for (int ai = 0; ai < 2; ++ai)
#pragma unroll
                for (int m = 0; m < 4; ++m) { const int row = row0 + ai * 128 + m * 16;
                    { const f32x4 v0 = acc[ai][0][m][0], v1 = acc[ai][0][m][1];
                      float s = (v0[0] * v0[0] + v0[1] * v0[1]) + (v0[2] * v0[2] + v0[3] * v0[3]) + (v1[0] * v1[0] + v1[1] * v1[1]) + (v1[2] * v1[2] + v1[3] * v1[3]);
                      st128(BCQ + (size_t)row * 384 + 256 + wc * 32 + 8 * fq, pack8(v0, v1));
                      s += xor16f(s, (fq & 1) != 0); s += xor32f(s, (fq & 2) != 0);
                      if (fq == 0) st32f(SSQ + (size_t)row * 8 + 4 + wc, s); }
                    if (wc == 0) { f32x4 v0 = acc[ai][1][m][0], v1 = acc[ai][1][m][1];
                      const int fi = (fq & 1) * 8;
                      const f32x4 c0 = *(const f32x4*)(COSM + (size_t)row * 16 + fi), c1 = *(const f32x4*)(COSM + (size_t)row * 16 + fi + 4);
                      f32x4 s0 = *(const f32x4*)(SINM + (size_t)row * 16 + fi), s1 = *(const f32x4*)(SINM + (size_t)row * 16 + fi + 4);
                      if (fq < 2) { s0 = -s0; s1 = -s1; }
                      const f32x4 p0 = shfl4<32>(v0, fq), p1 = shfl4<32>(v1, fq);
                      v0 = v0 * c0 + p0 * s0; v1 = v1 * c1 + p1 * s1;
                      st128(MKR + (size_t)row * 32 + 8 * fq, pack8(v0, v1)); } asm volatile("" ::: "memory"); }
        }
        else if (pn < 12) store_tile<true>(acc, CQ, 768, (pn - 9) * 256, row0, wc, fq, COSP, SINP);
        else if (pn < 15) store_tile<true>(acc, CK, 768, (pn - 12) * 256, row0, wc, fq, COSP, SINP);
        else store_tile<false>(acc, CV, 1536, (pn - 15) * 256, row0, wc, fq, COSP, SINP);
    }
};
struct EpiMq {
    __device__ __forceinline__ bool keep(const Unit&) const { return false; }
    bf16_t* MQ; const float *SSQ, *COSM, *SINM;
    __device__ __forceinline__ void operator()(const Acc& acc, const Unit& u, int wr, int wc, int fr, int fq) const {
        const int pn = u.pn, row0 = u.pm * 256 + wr * 64 + fr;
        float rstd[8];
#pragma unroll
        for (int ai = 0; ai < 2; ++ai) { f32x4 q0[4], q1[4];
#pragma unroll
          for (int m = 0; m < 4; ++m) { const float* sp = SSQ + (size_t)(row0 + ai * 128 + m * 16) * 8; q0[m] = *(const f32x4*)sp; q1[m] = *(const f32x4*)(sp + 4); }
#pragma unroll
          for (int m = 0; m < 4; ++m) rstd[ai * 4 + m] = 1.0f / sqrtf(((q0[m][0] + q0[m][1]) + (q0[m][2] + q0[m][3]) + (q1[m][0] + q1[m][1]) + (q1[m][2] + q1[m][3])) * (1.0f / 384.0f) + RMS_EPS);
          asm volatile("" ::: "memory"); }
        if (pn < 2) {
#pragma unroll
            for (int i = 0; i < 8; ++i) { const int row = row0 + (i >> 2) * 128 + (i & 3) * 16;
#pragma unroll
                for (int bj = 0; bj < 2; ++bj) { const int c = pn * 256 + bj * 128 + wc * 32 + 8 * fq, head = c >> 6, d = c & 63;
                    st128(MQ + (size_t)row * 768 + head * 96 + d, pack8(acc[i >> 2][bj][i & 3][0] * rstd[i], acc[i >> 2][bj][i & 3][1] * rstd[i])); } }
        } else {
            const int fi = (fq & 1) * 8;
#pragma unroll
            for (int h2 = 0; h2 < 4; ++h2) {
                f32x4 c0[2], c1[2], s0[2], s1[2];
#pragma unroll
                for (int q = 0; q < 2; ++q) { const int i = h2 * 2 + q; const size_t ro = (size_t)(row0 + (i >> 2) * 128 + (i & 3) * 16) * 16 + fi;
                    c0[q] = *(const f32x4*)(COSM + ro); c1[q] = *(const f32x4*)(COSM + ro + 4); s0[q] = *(const f32x4*)(SINM + ro); s1[q] = *(const f32x4*)(SINM + ro + 4); }
#pragma unroll
                for (int q = 0; q < 2; ++q) { const int i = h2 * 2 + q, ai = i >> 2, m = i & 3; const int row = row0 + ai * 128 + m * 16; const float rs = rstd[i];
                    if (fq < 2) { s0[q] = -s0[q]; s1[q] = -s1[q]; }
#pragma unroll
                    for (int bj = 0; bj < 2; ++bj) { f32x4 v0 = acc[ai][bj][m][0] * rs, v1 = acc[ai][bj][m][1] * rs;
                        const f32x4 p0 = shfl4<32>(v0, fq), p1 = shfl4<32>(v1, fq);
                        v0 = v0 * c0[q] + p0 * s0[q]; v1 = v1 * c1[q] + p1 * s1[q];
                        st128(MQ + (size_t)row * 768 + (bj * 4 + wc) * 96 + 64 + 8 * fq, pack8(v0, v1)); } }
                asm volatile("" ::: "memory"); }
        }
    }
};
struct EpiMkv {
    __device__ __forceinline__ bool keep(const Unit&) const { return false; }
    bf16_t *MK, *MV; const float* SSK;
    __device__ __forceinline__ void operator()(const Acc& acc, const Unit& u, int wr, int wc, int fr, int fq) const {
        const int pn = u.pn, row0 = u.pm * 256 + wr * 64 + fr; bf16_t* dst = (pn < 2 ? MK : MV) + (pn & 1) * 256 + wc * 32 + 8 * fq;
        f32x4 q[8];
#pragma unroll
        for (int i = 0; i < 8; ++i) q[i] = *(const f32x4*)(SSK + (size_t)(row0 + (i >> 2) * 128 + (i & 3) * 16) * 4);
#pragma unroll
        for (int i = 0; i < 8; ++i) { const int row = row0 + (i >> 2) * 128 + (i & 3) * 16;
            const float rstd = 1.0f / sqrtf(((q[i][0] + q[i][1]) + (q[i][2] + q[i][3])) * (1.0f / 256.0f) + RMS_EPS);
#pragma unroll
            for (int bj = 0; bj < 2; ++bj) st128(dst + (size_t)row * 512 + bj * 128, pack8(acc[i >> 2][bj][i & 3][0] * rstd, acc[i >> 2][bj][i & 3][1] * rstd)); }
    }
};
struct EpiSig {
    __device__ __forceinline__ bool keep(const Unit&) const { return false; }
    bf16_t* G; const float* bias;
    __device__ __forceinline__ void operator()(const Acc& acc, const Unit& u, int wr, int wc, int fr, int fq) const {
        const int row0 = u.pm * 256 + wr * 64 + fr, col0 = u.pn * 256 + wc * 32 + 8 * fq;
#pragma unroll
        for (int bj = 0; bj < 2; ++bj) { const f32x4 b0 = *(const f32x4*)(bias + col0 + bj * 128), b1 = *(const f32x4*)(bias + col0 + bj * 128 + 4);
#pragma unroll
            for (int ai = 0; ai < 2; ++ai)
#pragma unroll
                for (int m = 0; m < 4; ++m) { const int row = row0 + ai * 128 + m * 16; f32x4 v0 = acc[ai][bj][m][0] + b0, v1 = acc[ai][bj][m][1] + b1;
#pragma unroll
                    for (int j = 0; j < 4; ++j) { v0[j] = sigmoidf_(v0[j]); v1[j] = sigmoidf_(v1[j]); }
                    st128(G + (size_t)row * 3072 + col0 + bj * 128, pack8(v0, v1)); } }
    }
};
struct EpiGate {
    const bf16_t* G; bf16_t* YB; int nMc;
    __device__ __forceinline__ bool keep(const Unit& u) const { return (u.pn >> 2) < 2; }
    __device__ __forceinline__ void operator()(Acc& acc, const Unit& u, int wr, int wc, int fr, int fq) const {
        const int b = u.pn >> 2, pn = u.pn & 3, pm = u.pm - b * nMc;
        const int row0 = pm * 256 + wr * 64 + fr, col0 = pn * 256 + wc * 32 + 8 * fq;
        const bf16_t* gp0 = G + (size_t)row0 * 3072 + b * 1024 + col0;
#pragma unroll
        for (int ai = 0; ai < 2; ++ai) {
            u32x4 gq[4][2];
#pragma unroll
            for (int m = 0; m < 4; ++m)
#pragma unroll
                for (int bj = 0; bj < 2; ++bj) gq[m][bj] = *(const u32x4*)(gp0 + (size_t)(ai * 128 + m * 16) * 3072 + bj * 128);
            if (b < 2) {
#pragma unroll
                for (int m = 0; m < 4; ++m)
#pragma unroll
                    for (int bj = 0; bj < 2; ++bj) { f32x4 g0, g1; unpack8(gq[m][bj], g0, g1); acc[ai][bj][m][0] *= g0; acc[ai][bj][m][1] *= g1; }
                asm volatile("" ::: "memory");
#pragma unroll
                for (int m = 0; m < 4; ++m)
#pragma unroll
                    for (int bj = 0; bj < 2; ++bj) gq[m][bj] = *(const u32x4*)(gp0 + 1024 + (size_t)(ai * 128 + m * 16) * 3072 + bj * 128);
#pragma unroll
                for (int m = 0; m < 4; ++m)
#pragma unroll
                    for (int bj = 0; bj < 2; ++bj) { f32x4 h0, h1; unpack8(gq[m][bj], h0, h1);
#pragma unroll
                        for (int j = 0; j < 4; ++j) { acc[ai][bj][m][0][j] *= __builtin_amdgcn_rcpf(fmaxf(h0[j], 1e-20f)); acc[ai][bj][m][1][j] *= __builtin_amdgcn_rcpf(fmaxf(h1[j], 1e-20f)); } }
            } else {
#pragma unroll
                for (int m = 0; m < 4; ++m) { const int row = row0 + ai * 128 + m * 16;
#pragma unroll
                    for (int bj = 0; bj < 2; ++bj) { f32x4 g0, g1; unpack8(gq[m][bj], g0, g1);
                        st128(YB + (size_t)row * 1024 + col0 + bj * 128, pack8(acc[ai][bj][m][0] * g0, acc[ai][bj][m][1] * g1)); } }
            }
            asm volatile("" ::: "memory");
        }
    }
};
struct EpiBf16 {
    __device__ __forceinline__ bool keep(const Unit&) const { return false; }
    bf16_t* O; int ld;
    __device__ __forceinline__ void operator()(const Acc& acc, const Unit& u, int wr, int wc, int fr, int fq) const {
        const int row0 = u.pm * 256 + wr * 64 + fr, col0 = u.pn * 256 + wc * 32 + 8 * fq;
#pragma unroll
        for (int ai = 0; ai < 2; ++ai)
#pragma unroll
            for (int m = 0; m < 4; ++m) { const int row = row0 + ai * 128 + m * 16;
#pragma unroll
                for (int bj = 0; bj < 2; ++bj) st128(O + (size_t)row * ld + col0 + bj * 128, pack8(acc[ai][bj][m][0], acc[ai][bj][m][1])); }
    }
};
struct EpiSwiglu {
    __device__ __forceinline__ bool keep(const Unit&) const { return false; }
    bf16_t* HID;
    __device__ __forceinline__ void operator()(const Acc& acc, const Unit& u, int wr, int wc, int fr, int fq) const {
        const int row0 = u.pm * 256 + wr * 64 + fr, col0 = (u.pn & 1) * 128 + wc * 32 + 8 * fq;
#pragma unroll
        for (int ai = 0; ai < 2; ++ai)
#pragma unroll
            for (int m = 0; m < 4; ++m) { const int row = row0 + ai * 128 + m * 16; f32x4 h0, h1;
#pragma unroll
                for (int j = 0; j < 4; ++j) { const float g0 = acc[ai][0][m][0][j], g1 = acc[ai][0][m][1][j];
                    h0[j] = g0 * sigmoidf_(g0) * acc[ai][1][m][0][j]; h1[j] = g1 * sigmoidf_(g1) * acc[ai][1][m][1][j]; }
                st128(HID + (size_t)row * 256 + col0, pack8(h0, h1)); }
    }
};
struct EpiDown {
    __device__ __forceinline__ bool keep(const Unit&) const { return false; }
    bf16_t* Y; const int* ROWTOK; const float* ROWW;
    __device__ __forceinline__ void operator()(const Acc& acc, const Unit& u, int wr, int wc, int fr, int fq) const {
        const int row0 = u.pm * 256 + wr * 64 + fr, col0 = (u.pn & 3) * 256 + wc * 32 + 8 * fq;
        int rt[8]; float w[8];
#pragma unroll
        for (int i = 0; i < 8; ++i) { const int row = row0 + (i >> 2) * 128 + (i & 3) * 16; rt[i] = ROWTOK[row]; w[i] = ROWW[row]; }
#pragma unroll
        for (int ai = 0; ai < 2; ++ai)
#pragma unroll
            for (int m = 0; m < 4; ++m) { const int r = rt[ai * 4 + m];
                if (r >= 0) { const float ww = w[ai * 4 + m]; const int tok = r & 0xffffff, slot = r >> 24; bf16_t* yp = Y + ((size_t)slot * TC + tok) * 1024 + col0;
#pragma unroll
                    for (int bj = 0; bj < 2; ++bj) st128(yp + bj * 128, pack8(acc[ai][bj][m][0] * ww, acc[ai][bj][m][1] * ww)); } }
    }
};
struct MoeOrder {
    int nbr, NTL, G, c; const LAS int* blk_e;
    __device__ __forceinline__ int row_block(int i) const {
        const int cs = (G % 32) ? c : (NTL == 2 ? ((c >> 4) << 4) + 2 * (c & 7) + ((c >> 3) & 1) : ((c >> 5) << 5) + 4 * (c & 7) + ((c >> 3) & 3));
        const int L = i * G + cs; if (L >= (nbr + TC / 256) * NTL) return -1;
        const int blk = L / NTL; return blk < nbr ? blk : BASE_SH / 256 + (blk - nbr); }
    __device__ bool next(int i, Unit& u) const {
        const int cs = (G % 32) ? c : (NTL == 2 ? ((c >> 4) << 4) + 2 * (c & 7) + ((c >> 3) & 1) : ((c >> 5) << 5) + 4 * (c & 7) + ((c >> 3) & 3));
        const int L = i * G + cs; if (L >= (nbr + TC / 256) * NTL) return false;
        const int blk = L / NTL, j = L % NTL; int e;
        if (blk < nbr) { u.pm = blk; e = blk_e[blk]; } else { u.pm = BASE_SH / 256 + (blk - nbr); e = 16; }
        u.pn = e * NTL + j; return true;
    }
};
struct BranchOrder {
    int nMc, G, c;
    __device__ bool next(int i, Unit& u) const {
        const int cs = (G % 32) ? c : ((c >> 5) << 5) + 4 * (c & 7) + ((c >> 3) & 3);
        const int b = i % 3, L = (i / 3) * G + cs; if (L >= nMc * 4) return false;
        const int pm = L >> 2, pn = L & 3; u.pm = b * nMc + pm; u.pn = b * 4 + pn; return true;
    }
};

struct Args { GAS const void* in[31]; GAS float* out; GAS unsigned char* ws; int ph_lo, ph_hi; float invf_p[8]; float invf_m[16]; float lam_init[2]; float oml[2]; };
struct Frame { LAS unsigned char* lds; int tid, lane, wave, G, vcu; };
constexpr int NW = 8;

__device__ __forceinline__ void tr_item(const float* W, int ldw, int n_src0, int k0, bf16_t* WT, int ldt, int n_dst0, const float* ks, int ksmod, float scal, LAS float* scr, int lane) {
#pragma unroll 8
    for (int i = 0; i < 32; ++i) { const int kk = 2 * i + (lane >> 5); float v = W[(size_t)(k0 + kk) * ldw + n_src0 + (lane & 31)] * scal; if (ks) v *= ks[(k0 + kk) % ksmod]; scr[kk * 33 + (lane & 31)] = v; }
    asm volatile("s_waitcnt lgkmcnt(0)" ::: "memory");
    const int c = lane & 7;
#pragma unroll
    for (int j = 0; j < 4; ++j) { const int n = (lane >> 3) + 8 * j; const LAS float* s = scr + (8 * c) * 33 + n;
        u32x4 o; o.x = pk2(s[0 * 33], s[1 * 33]); o.y = pk2(s[2 * 33], s[3 * 33]); o.z = pk2(s[4 * 33], s[5 * 33]); o.w = pk2(s[6 * 33], s[7 * 33]);
        *(u32x4*)(WT + (size_t)(n_dst0 + n) * ldt + k0 + 8 * c) = o; }
    asm volatile("s_waitcnt lgkmcnt(0)" ::: "memory");
}
__device__ __forceinline__ void tr_seg(const Frame& F, int& ibase, const float* W, int K, int ldw, int src0, int len, bf16_t* WT, int dst0, const float* ks, int ksmod, float scal) {
    const int NGW = F.G * NW, gw = F.vcu * NW + F.wave, nblk = len / 32, n = (K / 64) * nblk;
    LAS float* scr = (LAS float*)(F.lds + F.wave * 16384);
    int start = gw - (ibase % NGW); if (start < 0) start += NGW;
    for (int it = start; it < n; it += NGW) { const int kb = it / nblk, nb = it % nblk; tr_item(W, ldw, src0 + 32 * nb, 64 * kb, WT, K, dst0 + 32 * nb, ks, ksmod, scal, scr, F.lane); }
    ibase += n;
}

#define DEFPTRS const int T0 = c * TC; \
    bf16_t* XB = (bf16_t*)(ws + R_XB); \
    float* COSP = (float*)(ws + R_RP); float* SINP = COSP + TCB * 8; float* COSM = SINP + TCB * 8; float* SINM = COSM + TCB * 16; \
    bf16_t* AQ = (bf16_t*)(ws + R_A); bf16_t* AK = AQ + TCB * 512; bf16_t* AV = AK + TCB * 512; \
    bf16_t* OAn = (bf16_t*)(ws + R_S); \
    bf16_t* OB = OAn + TCB * 512; bf16_t* OCn = OAn + TCB * 1024; \
    bf16_t* HID = AQ; \
    bf16_t* BCQ = (bf16_t*)(ws + R_B); bf16_t* BCKV = BCQ + TCB * 384; bf16_t* MKR = BCKV + TCB * 256; float* SSQ = (float*)(MKR + TCB * 32); float* SSK = SSQ + TCB * 8; \
    bf16_t* CQ = (bf16_t*)(ws + R_C); bf16_t* CK = CQ + TCB * 768; bf16_t* CV = CK + TCB * 768; \
    bf16_t* GT = CQ; bf16_t* YS = CQ; \
    bf16_t* OA = (bf16_t*)(ws + R_O); bf16_t* OCg = OA + TCB * 1024; float* LSE = (float*)(OCg + TCB * 1536); \
    float* YF = (float*)(ws + R_O); bf16_t* YB = (bf16_t*)(ws + R_O + TCB * 4096); float* MIX = YF; \
    bf16_t* XG = (bf16_t*)(ws + R_O); bf16_t* XB1 = XG + (size_t)BASE_SH * 1024; \
    bf16_t* MQ = (bf16_t*)(ws + R_M); bf16_t* MK = MQ + TCB * 768; bf16_t* MV = MK + TCB * 512; \
    int* ERT = (int*)(ws + R_O + TCB * 2048 + 4 * MiB); float* ERW = (float*)(ERT + 16 * TCB);        \
    int* TOKE = (int*)(ws + R_T); float* TOKW = (float*)(TOKE + TCB * 2); int* TOKP = (int*)(TOKW + TCB * 2); int* ROWTOK = TOKP + TCB * 2; float* ROWW = (float*)(ROWTOK + NROWS); \
    float* X = (float*)(ap->out + (size_t)T0 * D);
#define DEFL GAS unsigned char* wb = ws + WS_W + (size_t)l * WB_LAYER; unsigned* CNT = (unsigned*)(ws + WS_CTL) + CW_CNT + (c * DEPTH + l) * 64; (void)wb; (void)CNT;
__global__ void __launch_bounds__(NW * 64, 2) fwd_kernel(Args args) {
    extern __shared__ __attribute__((aligned(16))) unsigned char lds_raw[];
    LAS unsigned char* const lds0 = (LAS unsigned char*)lds_raw;
    for (int u = threadIdx.x; u < (LDS_BYTES - MISC_OFF) / 4; u += NW * 64) ((LAS unsigned*)(lds0 + MISC_OFF))[u] = 0u;
    __syncthreads();
    const int lo = args.ph_lo, hi = args.ph_hi;
    const bool multi = (hi - lo) > 1;
    XcdBarrier bar; bar.bar = (unsigned*)(args.ws + WS_CTL) + CW_BAR; bar.x = 0; bar.st = nullptr;
    if (multi) bar = xcd_barrier_post((unsigned*)(args.ws + WS_CTL) + CW_BAR, (volatile LAS unsigned*)(lds0 + MISC_OFF));
    int ph = 0;
    const int wave0 = __builtin_amdgcn_readfirstlane((int)threadIdx.x >> 6);
#ifndef SUBMASK
#define SUBMASK 0xFFu
#endif
#ifndef PHMASK
#define PHMASK 0xFFFFFFFFu
#endif
typedef const __attribute__((address_space(4))) Args CArgs;
#define PH_BEGIN if (ph >= lo && ph < hi) { CArgs* ap = (CArgs*)__builtin_amdgcn_kernarg_segment_ptr(); asm volatile("" : "+s"(ap)); GAS unsigned char* ws = ap->ws; (void)ws; \
    Frame F; asm volatile("v_mbcnt_lo_u32_b32 %0, -1, 0\n\tv_mbcnt_hi_u32_b32 %0, -1, %0" : "=v"(F.lane)); F.tid = wave0 * 64 + F.lane; F.lane = F.tid & 63; F.wave = __builtin_amdgcn_readfirstlane(F.tid >> 6); F.lds = lds0; F.G = gridDim.x; \
    { const int bx_ = blockIdx.x; F.vcu = (F.G % 8 == 0) ? (bx_ % 8) * (F.G / 8) + bx_ / 8 : bx_; } \
    const int gw = F.vcu * NW + F.wave, NGW = F.G * NW, bx = (int)blockIdx.x; (void)gw; (void)NGW; (void)bx;
#define PH_END if (ph + 1 < hi) xcd_barrier(bar); } ++ph;
    LAS int* OFFS = (LAS int*)(lds0 + MISC_OFF + 64);
    LAS int* NBR = (LAS int*)(lds0 + MISC_OFF + 192);
    LAS int* BLKE = (LAS int*)(lds0 + MISC_OFF + 256);

    PH_BEGIN if constexpr ((PHMASK >> 0) & 1)
    {
        int ibase = 0;
        for (int l = 0; l < DEPTH; ++l) {
            GAS unsigned char* wb = ws + WS_W + (size_t)l * WB_LAYER;
            bf16_t* Win = (bf16_t*)(wb + WB_IN);
            const float* w_in = (const float*)ap->in[4] + (size_t)l * 1024 * IN_WIDTH;
            tr_seg(F, ibase, w_in, 1024, IN_WIDTH, 0, 1920, Win, 0, nullptr, 1, 1.f);
            tr_seg(F, ibase, w_in, 1024, IN_WIDTH, 2176, 32, Win, 1920, nullptr, 1, 1.f);
            tr_seg(F, ibase, w_in, 1024, IN_WIDTH, 1920, 256, Win, 2048, nullptr, 1, 1.f);
            tr_seg(F, ibase, w_in, 1024, IN_WIDTH, 2208, 6144, Win, 2304, nullptr, 1, 1.f);
            for (int i = bx * 512 + F.tid; i < 96 * 1024 / 8; i += F.G * 512) *(u32x4*)(Win + (size_t)1952 * 1024 + (size_t)i * 8) = (u32x4){0u, 0u, 0u, 0u};
            const float* w_qb = (const float*)ap->in[13] + (size_t)l * 384 * 768; const float* qg = (const float*)ap->in[11] + l * 384;
            const float* w_kvb = (const float*)ap->in[14] + (size_t)l * 256 * 1024; const float* kvg = (const float*)ap->in[12] + l * 256;
            for (int h = 0; h < 8; ++h) {
                tr_seg(F, ibase, w_qb, 384, 768, h * 96, 64, (bf16_t*)(wb + WB_QB), h * 64, qg, 384, 1.f);
                tr_seg(F, ibase, w_qb, 384, 768, h * 96 + 64, 32, (bf16_t*)(wb + WB_QB), 512 + h * 32, qg, 384, 1.f);
                tr_seg(F, ibase, w_kvb, 256, 1024, h * 128, 64, (bf16_t*)(wb + WB_KVB), h * 64, kvg, 256, 1.f);
                tr_seg(F, ibase, w_kvb, 256, 1024, h * 128 + 64, 64, (bf16_t*)(wb + WB_KVB), 512 + h * 64, kvg, 256, 1.f);
            }
            tr_seg(F, ibase, (const float*)ap->in[15] + (size_t)l * 512 * 1024, 512, 1024, 0, 1024, (bf16_t*)(wb + WB_BR), 0, (const float*)ap->in[10] + l * 128, 128, ap->oml[l]);
            tr_seg(F, ibase, (const float*)ap->in[16] + (size_t)l * 512 * 1024, 512, 1024, 0, 1024, (bf16_t*)(wb + WB_BR), 1024, nullptr, 1, 1.f);
            tr_seg(F, ibase, (const float*)ap->in[17] + (size_t)l * 512 * 1024, 512, 1024, 0, 1024, (bf16_t*)(wb + WB_BR), 2048, nullptr, 1, 1.f);
            tr_seg(F, ibase, (const float*)ap->in[18] + (size_t)l * 1024 * 1024, 1024, 1024, 0, 1024, (bf16_t*)(wb + WB_OUT), 0, nullptr, 1, 1.f);
            for (int e = 0; e < 17; ++e) {
                const float* wg = e < 16 ? (const float*)ap->in[23] + ((size_t)l * 16 + e) * 1024 * 256 : (const float*)ap->in[26] + (size_t)l * 1024 * 256;
                const float* wu = e < 16 ? (const float*)ap->in[24] + ((size_t)l * 16 + e) * 1024 * 256 : (const float*)ap->in[27] + (size_t)l * 1024 * 256;
                const float* wd = e < 16 ? (const float*)ap->in[25] + ((size_t)l * 16 + e) * 256 * 1024 : (const float*)ap->in[28] + (size_t)l * 256 * 1024;
                for (int j = 0; j < 2; ++j) {
                    tr_seg(F, ibase, wg, 1024, 256, j * 128, 128, (bf16_t*)(wb + WB_W1), e * 512 + j * 256, nullptr, 1, 1.f);
                    tr_seg(F, ibase, wu, 1024, 256, j * 128, 128, (bf16_t*)(wb + WB_W1), e * 512 + j * 256 + 128, nullptr, 1, 1.f);
                }
                tr_seg(F, ibase, wd, 256, 1024, 0, 1024, (bf16_t*)(wb + WB_W2), e * 1024, nullptr, 1, 1.f);
            }
        }
    }
        { const int c = 0;
        { DEFPTRS
            const float* xin = (const float*)ap->in[0] + (size_t)T0 * D; const int* pos = (const int*)ap->in[1] + T0;
            const float* g = (const float*)ap->in[2]; const float* b = (const float*)ap->in[3];
            f32x4 gv[4], bv[4];
#pragma unroll
            for (int j = 0; j < 4; ++j) { gv[j] = *(const f32x4*)(g + 4 * F.lane + 256 * j); bv[j] = *(const f32x4*)(b + 4 * F.lane + 256 * j); }
            const float invf = F.lane < 8 ? ap->invf_p[F.lane & 7] : ap->invf_m[(F.lane - 8) & 15];
            f32x4 nv[4]; int npos = pos[gw];
#pragma unroll
            for (int j = 0; j < 4; ++j) nv[j] = ((const f32x4*)(xin + (size_t)gw * D) + F.lane)[64 * j];
            for (int t = gw; t < TC; t += NGW) {
                f32x4 v[4]; float s = 0.f; const int cpos = npos;
#pragma unroll
                for (int j = 0; j < 4; ++j) v[j] = nv[j];
                if (t + NGW < TC) { npos = pos[t + NGW];
#pragma unroll
                    for (int j = 0; j < 4; ++j) nv[j] = ((const f32x4*)(xin + (size_t)(t + NGW) * D) + F.lane)[64 * j]; }
#pragma unroll
                for (int j = 0; j < 4; ++j) s += (v[j][0] + v[j][1]) + (v[j][2] + v[j][3]);
                const float mean = wave_sum(s) * (1.f / D); float s2 = 0.f;
#pragma unroll
                for (int j = 0; j < 4; ++j) { v[j] = v[j] - mean; s2 += (v[j][0] * v[j][0] + v[j][1] * v[j][1]) + (v[j][2] * v[j][2] + v[j][3] * v[j][3]); }
                const float rstd = 1.0f / sqrtf(wave_sum(s2) * (1.f / D) + LN_EPS);
#pragma unroll
                for (int j = 0; j < 4; ++j) { v[j] = v[j] * rstd * gv[j] + bv[j];
                    u32x2 w; w.x = pk2(v[j][0], v[j][1]); w.y = pk2(v[j][2], v[j][3]); st64((u32x2*)(XB + (size_t)t * D) + F.lane + 64 * j, w); }
                if (F.lane < 24) {
                    const float ang = (float)cpos * invf;
                    const double rev = (double)ang * 0.15915494309189535; const float fr = (float)(rev - __builtin_rint(rev));
                    const float cs = __builtin_amdgcn_cosf(fr), sn = __builtin_amdgcn_sinf(fr);
                    if (F.lane < 8) { st32f(COSP + (size_t)t * 8 + F.lane, cs); st32f(SINP + (size_t)t * 8 + F.lane, sn); }
                    else { st32f(COSM + (size_t)t * 16 + F.lane - 8, cs); st32f(SINM + (size_t)t * 16 + F.lane - 8, sn); }
                }
            }
        }
        }
    PH_END

    for (int c = 0; c < NCHUNK; ++c) {


        for (int l = 0; l < DEPTH; ++l) {
            PH_BEGIN if constexpr ((PHMASK >> 2) & 1)
            { DEFPTRS DEFL
                pg8::Gemm g{XB, (const bf16_t*)(wb + WB_IN), 1024, 1024, 1024}; pg8::StaticOrder S; S.init(TC, NIN_A, F.G, bx);
                EpiIn E{ws};
                pg8::gemm_phase(F.lds, fresh(F.tid), g, S, E);
            }
            PH_END
            PH_BEGIN if constexpr ((PHMASK >> 3) & 1)
            { DEFPTRS DEFL
                if constexpr (SUBMASK & 8) for (int uidx = bx; uidx < NBC * 3 * 4 * 32; uidx += F.G) { const int x = uidx & 31, h = (uidx >> 5) & 3, gi = (uidx >> 7) % 3, b = uidx / 384;
                    const int dil = gi == 0 ? 1 : (gi == 1 ? 4 : 16), L = SEQ / dil, r = x % dil, jb = x / dil; const size_t tok0 = (size_t)b * SEQ + r; const int hc = gi * 4 + h;
                    att::band_unit(CQ + tok0 * 768 + hc * 64, 768, CK + tok0 * 768 + hc * 64, 768, CV + tok0 * 1536 + hc * 128, 1536,
                                   OCg + (size_t)gi * TCB * 512 + tok0 * 512 + h * 128, 512, LSE + tok0 * 12 + hc, 12, dil, L, jb * 256, 0.125f * LOG2E, 0.125f, (LAS char*)F.lds, fresh(F.tid)); }
                if constexpr (SUBMASK & 4) {
                    float lam;
                    { const float a = ((const float*)ap->in[6])[l * 64 + F.lane] * ((const float*)ap->in[7])[l * 64 + F.lane], bq = ((const float*)ap->in[8])[l * 64 + F.lane] * ((const float*)ap->in[9])[l * 64 + F.lane];
                      lam = __expf(wave_sum(a)) - __expf(wave_sum(bq)) + ap->lam_init[l]; lam = __uint_as_float((unsigned)__builtin_amdgcn_readfirstlane((int)__float_as_uint(lam))); }
                    for (int uu = bx; uu < NBC * 4 * 32; uu += F.G) { const int rr = uu & 255, bh = (uu >> 8) * 8 + (rr & 7), qb = rr >> 3;
                        const int b = bh >> 2, h = bh & 3; const size_t tb = (size_t)b * SEQ;
                        _Pragma("unroll")
                        for (int m = 0; m < 2; ++m) { const int hm = 2 * h + m; bf16_t* O1 = OA + (tb + qb * 256) * 1024 + (2 * h) * 128;
                            att::dense_unit_dma(AQ + (tb + qb * 256) * 512 + hm * 64, 512, AK + tb * 512 + hm * 64, 512, AV + tb * 512 + h * 128, 512,
                                                m == 0 ? O1 : OAn + (tb + qb * 256) * 512 + h * 128, m == 0 ? 1024 : 512, SEQ, 0.125f * LOG2E, 64.f, (LAS char*)F.lds, fresh(F.tid), m, lam, O1, 1024); } } }
                if constexpr (SUBMASK & 1) { pg8::Gemm g{BCQ, (const bf16_t*)(wb + WB_QB), 384, 384, 384}; pg8::StaticOrder S; S.init(TC, 768, F.G, bx); EpiMq E{MQ, SSQ, COSM, SINM}; pg8::gemm_phase(F.lds, fresh(F.tid), g, S, E); }
                if constexpr (SUBMASK & 2) { pg8::Gemm g{BCKV, (const bf16_t*)(wb + WB_KVB), 256, 256, 256}; pg8::StaticOrder S; S.init(TC, 1024, F.G, bx); EpiMkv E{MK, MV, SSK}; pg8::gemm_phase(F.lds, fresh(F.tid), g, S, E); }
            }
            PH_END
            PH_BEGIN if constexpr ((PHMASK >> 4) & 1)
            { DEFPTRS DEFL
                const float cm = 0.10206207261596575f;
                if constexpr (SUBMASK & 16) for (int uu = bx; uu < NBC * 8 * 16; uu += F.G) { const int rr = uu & 255, bh = (uu >> 8) * 16 + (rr & 7) * 2 + ((rr >> 3) & 1), qb = rr >> 4;
                    const int b = bh >> 3, h = bh & 7; const size_t tb = (size_t)b * SEQ;
                    att::dense_unit64_hp(MQ + (tb + qb * 512) * 768 + h * 96, 768, MK + tb * 512 + h * 64, 512, MKR + tb * 32, 32, MV + tb * 512 + h * 64, 512,
                                              OB + (tb + qb * 512) * 512 + h * 64, 512, SEQ, cm * LOG2E, 8.f / cm, (LAS char*)F.lds, new_tid(wave0)); }
                if constexpr (SUBMASK & 16) { F.tid = new_tid(wave0); F.lane = F.tid & 63; }
                {
                    const int h = F.lane >> 4, e0 = (F.lane & 15) * 8;
#define THIN_LOAD(tt) do { const size_t t_ = (size_t)(tt); \
                        nC = *(const u32x4*)(OCg + t_ * 512 + h * 128 + e0); nD = *(const u32x4*)(OCg + TCB * 512 + t_ * 512 + h * 128 + e0); nF = *(const u32x4*)(OCg + 2 * TCB * 512 + t_ * 512 + h * 128 + e0); \
                        nl0 = LSE[t_ * 12 + h]; nl1 = LSE[t_ * 12 + 4 + h]; nl2 = LSE[t_ * 12 + 8 + h]; } while (0)
                    u32x4 nC, nD, nF; float nl0, nl1, nl2;
                    THIN_LOAD(gw);
                    for (int t = gw; t < TC; t += NGW) {
                        const u32x4 cC = nC, cD = nD, cF = nF; const float l0 = nl0, l1 = nl1, l2 = nl2;
                        if (t + NGW < TC) THIN_LOAD(t + NGW);
                        const float mx = fmaxf(l0, fmaxf(l1, l2)); float w0 = __expf(l0 - mx), w1 = __expf(l1 - mx), w2 = __expf(l2 - mx); const float ri = 1.0f / (w0 + w1 + w2); w0 *= ri; w1 *= ri; w2 *= ri;
                        f32x4 c0, c1, d0, d1, f0, f1; unpack8(cC, c0, c1); unpack8(cD, d0, d1); unpack8(cF, f0, f1);
                        st128(OCn + (size_t)t * 512 + h * 128 + e0, pack8(w0 * c0 + w1 * d0 + w2 * f0, w0 * c1 + w1 * d1 + w2 * f1));
                    }
#undef THIN_LOAD
                }
                __syncthreads();
                if constexpr (SUBMASK & 64) { pg8::Gemm g{XB, (const bf16_t*)(wb + WB_IN) + (size_t)NIN_A * 1024, 1024, 1024, 1024}; pg8::StaticOrder S; S.init(TC, 3072, F.G, bx);
                  EpiSig E{GT, (const float*)ap->in[5] + l * 3072}; pg8::gemm_phase(F.lds, fresh(F.tid), g, S, E); }
            }
            PH_END
            PH_BEGIN if constexpr ((PHMASK >> 5) & 1)
            { DEFPTRS DEFL
                pg8::Gemm g{OAn, (const bf16_t*)(wb + WB_BR), 512, 512, 512}; BranchOrder S{TC / 256, F.G, bx}; EpiGate E{GT, YB, TC / 256};
                pg8::gemm_phase(F.lds, fresh(F.tid), g, S, E);
            }
            PH_END
            PH_BEGIN if constexpr ((PHMASK >> 6) & 1)
            { DEFPTRS DEFL
                pg8::Gemm g{YB, (const bf16_t*)(wb + WB_OUT), 1024, 1024, 1024}; pg8::StaticOrder S; S.init(TC, 1024, F.G, bx); EpiBf16 E{(bf16_t*)MIX, 1024};
                pg8::gemm_phase(F.lds, fresh(F.tid), g, S, E);
            }
            PH_END
            PH_BEGIN if constexpr ((PHMASK >> 7) & 1)
            { DEFPTRS DEFL
                LAS char* WL = (LAS char*)F.lds;
                LAS char* XW = (LAS char*)F.lds + 65536 + F.wave * 8192;
                LAS unsigned* LCNT = (LAS unsigned*)(F.lds + MISC_OFF + 4096);
                const float* rw = (const float*)ap->in[21];
                for (int i = F.tid; i < 16384; i += 512) { const int k = i >> 4, ex = i & 15; const float w = rw[i];
                    const unsigned hb = pk2(w, 0.f) & 0xffffu; const unsigned lb = pk2(w - __uint_as_float(hb << 16), 0.f) & 0xffffu;
                    const int hf = ex >> 3, grp = (ex >> 2) & 1, q4 = ex & 3, mh = ((grp * 2) * 2 + hf) * 4 + q4, ml = ((grp * 2 + 1) * 2 + hf) * 4 + q4;
                    *(LAS bf16_t*)(WL + mh * 2048 + (((k >> 3) ^ (mh & 15)) << 4) + (k & 7) * 2) = (bf16_t)hb;
                    *(LAS bf16_t*)(WL + ml * 2048 + (((k >> 3) ^ (ml & 15)) << 4) + (k & 7) * 2) = (bf16_t)lb; }
                if (F.tid < 16) LCNT[F.tid] = 0u;
                __syncthreads();
                const float* g = (const float*)ap->in[19] + l * D; const float* b = (const float*)ap->in[20] + l * D; const float* rbias = (const float*)ap->in[22];
                f32x4 gv[4], bv[4];
#pragma unroll
                for (int j = 0; j < 4; ++j) { gv[j] = *(const f32x4*)(g + 4 * F.lane + 256 * j); bv[j] = *(const f32x4*)(b + 4 * F.lane + 256 * j); }
                const int r32 = F.lane & 31, hi = F.lane >> 5;
                int me1 = 0, me2 = 0; unsigned mp1 = 0, mp2 = 0; float mw1 = 0.f, mw2 = 0.f;
                int it = 0;
                u32x2 nmw[4], nxw[4];
#pragma unroll
                for (int j = 0; j < 4; ++j) { nmw[j] = *((const u32x2*)((const bf16_t*)MIX + (size_t)gw * D) + F.lane + 64 * j); nxw[j] = *((const u32x2*)(XB + (size_t)gw * D) + F.lane + 64 * j); }
                for (int t = gw; t < TC; t += NGW, ++it) {
                    f32x4 v[4]; float s = 0.f; u32x2 cmw[4], cxw[4];
#pragma unroll
                    for (int j = 0; j < 4; ++j) { cmw[j] = nmw[j]; cxw[j] = nxw[j]; }
                    if (t + NGW < TC) {
#pragma unroll
                        for (int j = 0; j < 4; ++j) { nmw[j] = *((const u32x2*)((const bf16_t*)MIX + (size_t)(t + NGW) * D) + F.lane + 64 * j); nxw[j] = *((const u32x2*)(XB + (size_t)(t + NGW) * D) + F.lane + 64 * j); } }
#pragma unroll
                    for (int j = 0; j < 4; ++j) { const u32x2 mw = cmw[j]; const f32x4 mv = {__uint_as_float(mw.x << 16), __uint_as_float(mw.x & 0xffff0000u), __uint_as_float(mw.y << 16), __uint_as_float(mw.y & 0xffff0000u)};
                        const u32x2 xw = cxw[j]; const f32x4 xv = {__uint_as_float(xw.x << 16), __uint_as_float(xw.x & 0xffff0000u), __uint_as_float(xw.y << 16), __uint_as_float(xw.y & 0xffff0000u)};
                        v[j] = ALPHA * xv + mv; s += (v[j][0] + v[j][1]) + (v[j][2] + v[j][3]); }
                    const float mean = wave_sum(s) * (1.f / D); float s2 = 0.f;
#pragma unroll
                    for (int j = 0; j < 4; ++j) { v[j] = v[j] - mean; s2 += (v[j][0] * v[j][0] + v[j][1] * v[j][1]) + (v[j][2] * v[j][2] + v[j][3] * v[j][3]); }
                    const float rstd = 1.0f / sqrtf(wave_sum(s2) * (1.f / D) + LN_EPS);
                    const int q = it & 3;
#pragma unroll
                    for (int j = 0; j < 4; ++j) { v[j] = v[j] * rstd * gv[j] + bv[j];
                        u32x2 w; w.x = pk2(v[j][0], v[j][1]); w.y = pk2(v[j][2], v[j][3]); st64((u32x2*)(XB1 + (size_t)t * D) + F.lane + 64 * j, w);
                        *(LAS u32x2*)(XW + q * 2048 + ((((F.lane >> 1) + 32 * j) ^ q) << 4) + (F.lane & 1) * 8) = w; }
                    if (q != 3 && t + NGW < TC) continue;
                    f32x16 acc = f32x16{};
#pragma unroll 8
                    for (int ks = 0; ks < 64; ++ks) { const int ch = ks * 2 + hi;
                        const bf16x8 wa = *(const LAS bf16x8*)(WL + r32 * 2048 + ((ch ^ (r32 & 15)) << 4)), xb = *(const LAS bf16x8*)(XW + (r32 & 3) * 2048 + ((ch ^ (r32 & 3)) << 4));
                        acc = __builtin_amdgcn_mfma_f32_32x32x16_bf16(wa, xb, acc, 0, 0, 0); }
                    float sc[8], bsd[8];
#pragma unroll
                    for (int e8 = 0; e8 < 4; ++e8) { sc[e8] = sigmoidf_(acc[e8] + acc[4 + e8]); sc[4 + e8] = sigmoidf_(acc[8 + e8] + acc[12 + e8]); }
#pragma unroll
                    for (int e8 = 0; e8 < 8; ++e8) bsd[e8] = sc[e8] + rbias[hi * 8 + e8];
                    float gs[2];
#pragma unroll
                    for (int gI = 0; gI < 2; ++gI) { const float a0 = bsd[4 * gI], a1 = bsd[4 * gI + 1], a2 = bsd[4 * gI + 2], a3 = bsd[4 * gI + 3];
                        const float m1 = fmaxf(fmaxf(a0, a1), fmaxf(a2, a3));
                        float m2; if (a0 == m1) m2 = fmaxf(a1, fmaxf(a2, a3)); else if (a1 == m1) m2 = fmaxf(a0, fmaxf(a2, a3)); else if (a2 == m1) m2 = fmaxf(a0, fmaxf(a1, a3)); else m2 = fmaxf(a0, fmaxf(a1, a2));
                        gs[gI] = m1 + m2; }
                    const int gl = gs[1] > gs[0] ? 1 : 0; const float gbest = gl ? gs[1] : gs[0];
                    const float c0 = gl ? bsd[4] : bsd[0], c1 = gl ? bsd[5] : bsd[1], c2 = gl ? bsd[6] : bsd[2], c3 = gl ? bsd[7] : bsd[3];
                    const float u0 = gl ? sc[4] : sc[0], u1 = gl ? sc[5] : sc[1], u2 = gl ? sc[6] : sc[2], u3 = gl ? sc[7] : sc[3];
                    int i1 = 0; float b1 = c0; if (c1 > b1) { b1 = c1; i1 = 1; } if (c2 > b1) { b1 = c2; i1 = 2; } if (c3 > b1) { b1 = c3; i1 = 3; }
                    int i2 = -1; float b2 = -INFINITY;
                    if (i1 != 0 && c0 > b2) { b2 = c0; i2 = 0; } if (i1 != 1 && c1 > b2) { b2 = c1; i2 = 1; } if (i1 != 2 && c2 > b2) { b2 = c2; i2 = 2; } if (i1 != 3 && c3 > b2) { b2 = c3; i2 = 3; }
                    const float s1v = i1 == 0 ? u0 : i1 == 1 ? u1 : i1 == 2 ? u2 : u3, s2v = i2 == 0 ? u0 : i2 == 1 ? u1 : i2 == 2 ? u2 : u3;
                    const int gsel = 2 * hi + gl, e1v = gsel * 4 + i1, e2v = gsel * 4 + i2;
                    float other; { auto rr = __builtin_amdgcn_permlane32_swap(__float_as_uint(gbest), __float_as_uint(gbest), false, false); other = __uint_as_float(hi ? rr[0] : rr[1]); }
                    const int win = hi ? (gbest > other ? 1 : 0) : (other > gbest ? 0 : 1);
                    for (int qq = 0; qq <= q; ++qq) {
                        const int wl = __builtin_amdgcn_readlane(win, qq) ? qq : 32 + qq;
                        const int e1 = __builtin_amdgcn_readlane(e1v, wl), e2 = __builtin_amdgcn_readlane(e2v, wl);
                        const float s1 = __uint_as_float((unsigned)__builtin_amdgcn_readlane((int)__float_as_uint(s1v), wl)), s2 = __uint_as_float((unsigned)__builtin_amdgcn_readlane((int)__float_as_uint(s2v), wl));
                        const float inv = 1.0f / (s1 + s2);
                        unsigned p1 = 0, p2 = 0;
                        if (F.lane == 0) { p1 = __hip_atomic_fetch_add(LCNT + e1, 1u, __ATOMIC_RELAXED, __HIP_MEMORY_SCOPE_WORKGROUP); p2 = __hip_atomic_fetch_add(LCNT + e2, 1u, __ATOMIC_RELAXED, __HIP_MEMORY_SCOPE_WORKGROUP); }
                        p1 = (unsigned)__builtin_amdgcn_readfirstlane((int)p1); p2 = (unsigned)__builtin_amdgcn_readfirstlane((int)p2);
                        if (F.lane == it - q + qq) { me1 = e1; me2 = e2; mp1 = p1; mp2 = p2; mw1 = s1 * inv; mw2 = s2 * inv; } }
                }
                __syncthreads();
                if (F.tid < 16) { const unsigned n = LCNT[F.tid]; LCNT[16 + F.tid] = n ? __hip_atomic_fetch_add(CNT + F.tid, n, __ATOMIC_RELAXED, __HIP_MEMORY_SCOPE_AGENT) : 0u; }
                __syncthreads();
                if (F.lane < it) { const int t = gw + F.lane * NGW;
                    const unsigned g1 = mp1 + LCNT[16 + me1], g2 = mp2 + LCNT[16 + me2];
                    st32(ERT + (size_t)me1 * TC + g1, (unsigned)t); st32f(ERW + (size_t)me1 * TC + g1, mw1);
                    st32(ERT + (size_t)me2 * TC + g2, (unsigned)(t | (1 << 24))); st32f(ERW + (size_t)me2 * TC + g2, mw2); }
                __syncthreads();
            }
            PH_END
            PH_BEGIN if constexpr ((PHMASK >> 9) & 1)
            { DEFPTRS DEFL
                if (F.tid == 0) { int acc = 0; _Pragma("clang loop unroll(disable)") for (int e = 0; e < 16; ++e) { const int nb = ((int)CNT[e] + 255) >> 8; OFFS[e] = acc; _Pragma("clang loop vectorize(disable) unroll(disable)") for (int q = 0; q < nb; ++q) BLKE[acc + q] = e; acc += nb; } NBR[0] = acc; }
                __syncthreads();
                pg8::Gemm g{XB1, (const bf16_t*)(wb + WB_W1), 1024, 1024, 1024}; MoeOrder S{NBR[0], 2, F.G, bx, BLKE}; EpiSwiglu E{HID};
                { const int tl = fresh(F.tid);
                  _Pragma("clang loop unroll(disable)")
                  for (int un = 0; un < 8; ++un) { const int pmu = S.row_block(un); if (pmu < 0) break;
                      if (tl < 256) { int v; float w;
                          if (pmu >= BASE_SH / 256) { v = ((pmu - BASE_SH / 256) * 256 + tl) | (2 << 24); w = 1.f; }
                          else { const int e = BLKE[pmu], pos = (pmu - OFFS[e]) * 256 + tl; const bool ok = pos < (int)CNT[e];
                                 v = ok ? ERT[(size_t)e * TC + pos] : -1; w = ok ? ERW[(size_t)e * TC + pos] : 0.f; }
                          st32(ROWTOK + pmu * 256 + tl, (unsigned)v); st32f(ROWW + pmu * 256 + tl, w); } }
                  asm volatile("s_waitcnt vmcnt(0)" ::: "memory"); }
                __syncthreads();
                pg8::gemm_phase<EpiSwiglu, MoeOrder, true>(F.lds, fresh(F.tid), g, S, E, ROWTOK);
            }
            PH_END
            PH_BEGIN if constexpr ((PHMASK >> 10) & 1)
            { DEFPTRS DEFL
                if (F.tid == 0) { int acc = 0; _Pragma("clang loop unroll(disable)") for (int e = 0; e < 16; ++e) { const int nb = ((int)CNT[e] + 255) >> 8; OFFS[e] = acc; _Pragma("clang loop vectorize(disable) unroll(disable)") for (int q = 0; q < nb; ++q) BLKE[acc + q] = e; acc += nb; } NBR[0] = acc; }
                __syncthreads();
                pg8::Gemm g{HID, (const bf16_t*)(wb + WB_W2), 256, 256, 256}; MoeOrder S{NBR[0], 4, F.G, bx, BLKE}; EpiDown E{YS, ROWTOK, ROWW};
                pg8::gemm_phase(F.lds, fresh(F.tid), g, S, E);
            }
            PH_END
            PH_BEGIN if constexpr ((PHMASK >> 11) & 1)
            { DEFPTRS DEFL
                const float* g = (const float*)ap->in[29] + l * D; const float* b = (const float*)ap->in[30] + l * D;
                f32x4 gv[4], bv[4];
#pragma unroll
                for (int j = 0; j < 4; ++j) { gv[j] = *(const f32x4*)(g + 4 * F.lane + 256 * j); bv[j] = *(const f32x4*)(b + 4 * F.lane + 256 * j); }
                u32x2 nx[4], ny[3][4];
#pragma unroll
                for (int j = 0; j < 4; ++j) { nx[j] = *((const u32x2*)(XB1 + (size_t)gw * D) + F.lane + 64 * j);
#pragma unroll
                    for (int k = 0; k < 3; ++k) ny[k][j] = *((const u32x2*)(YS + ((size_t)k * TC + gw) * D) + F.lane + 64 * j); }
                for (int t = gw; t < TC; t += NGW) {
                    f32x4 v[4]; float s = 0.f; u32x2 cx[4], cy[3][4];
#pragma unroll
                    for (int j = 0; j < 4; ++j) { cx[j] = nx[j];
#pragma unroll
                        for (int k = 0; k < 3; ++k) cy[k][j] = ny[k][j]; }
                    if (t + NGW < TC) { const size_t tn = (size_t)(t + NGW);
#pragma unroll
                        for (int j = 0; j < 4; ++j) { nx[j] = *((const u32x2*)(XB1 + tn * D) + F.lane + 64 * j);
#pragma unroll
                            for (int k = 0; k < 3; ++k) ny[k][j] = *((const u32x2*)(YS + ((size_t)k * TC + tn) * D) + F.lane + 64 * j); } }
#pragma unroll
                    for (int j = 0; j < 4; ++j) { { const u32x2 xw = cx[j]; v[j] = ALPHA * (f32x4){__uint_as_float(xw.x << 16), __uint_as_float(xw.x & 0xffff0000u), __uint_as_float(xw.y << 16), __uint_as_float(xw.y & 0xffff0000u)}; }
#pragma unroll
                        for (int k = 0; k < 3; ++k) { const u32x2 w = cy[k][j];
                            v[j][0] += __uint_as_float(w.x << 16); v[j][1] += __uint_as_float(w.x & 0xffff0000u); v[j][2] += __uint_as_float(w.y << 16); v[j][3] += __uint_as_float(w.y & 0xffff0000u); }
                        s += (v[j][0] + v[j][1]) + (v[j][2] + v[j][3]); }
                    const float mean = wave_sum(s) * (1.f / D); float s2 = 0.f;
#pragma unroll
                    for (int j = 0; j < 4; ++j) { v[j] = v[j] - mean; s2 += (v[j][0] * v[j][0] + v[j][1] * v[j][1]) + (v[j][2] * v[j][2] + v[j][3] * v[j][3]); }
                    const float rstd = 1.0f / sqrtf(wave_sum(s2) * (1.f / D) + LN_EPS);
#pragma unroll
                    for (int j = 0; j < 4; ++j) { v[j] = v[j] * rstd * gv[j] + bv[j];
                        if (l == DEPTH - 1) st128f((f32x4*)(X + (size_t)t * D) + F.lane + 64 * j, v[j]);
                        else { u32x2 w; w.x = pk2(v[j][0], v[j][1]); w.y = pk2(v[j][2], v[j][3]); st64((u32x2*)(XB + (size_t)t * D) + F.lane + 64 * j, w); } }
                }
                if (l == DEPTH - 1 && c + 1 < NCHUNK) { const int cn_ = c + 1; { const int c = cn_;
        { DEFPTRS
            const float* xin = (const float*)ap->in[0] + (size_t)T0 * D; const int* pos = (const int*)ap->in[1] + T0;
            const float* g = (const float*)ap->in[2]; const float* b = (const float*)ap->in[3];
            f32x4 gv[4], bv[4];
#pragma unroll
            for (int j = 0; j < 4; ++j) { gv[j] = *(const f32x4*)(g + 4 * F.lane + 256 * j); bv[j] = *(const f32x4*)(b + 4 * F.lane + 256 * j); }
            const float invf = F.lane < 8 ? ap->invf_p[F.lane & 7] : ap->invf_m[(F.lane - 8) & 15];
            f32x4 nv[4]; int npos = pos[gw];
#pragma unroll
            for (int j = 0; j < 4; ++j) nv[j] = ((const f32x4*)(xin + (size_t)gw * D) + F.lane)[64 * j];
            for (int t = gw; t < TC; t += NGW) {
                f32x4 v[4]; float s = 0.f; const int cpos = npos;
#pragma unroll
                for (int j = 0; j < 4; ++j) v[j] = nv[j];
                if (t + NGW < TC) { npos = pos[t + NGW];
#pragma unroll
                    for (int j = 0; j < 4; ++j) nv[j] = ((const f32x4*)(xin + (size_t)(t + NGW) * D) + F.lane)[64 * j]; }
#pragma unroll
                for (int j = 0; j < 4; ++j) s += (v[j][0] + v[j][1]) + (v[j][2] + v[j][3]);
                const float mean = wave_sum(s) * (1.f / D); float s2 = 0.f;
#pragma unroll
                for (int j = 0; j < 4; ++j) { v[j] = v[j] - mean; s2 += (v[j][0] * v[j][0] + v[j][1] * v[j][1]) + (v[j][2] * v[j][2] + v[j][3] * v[j][3]); }
                const float rstd = 1.0f / sqrtf(wave_sum(s2) * (1.f / D) + LN_EPS);
#pragma unroll
                for (int j = 0; j < 4; ++j) { v[j] = v[j] * rstd * gv[j] + bv[j];
                    u32x2 w; w.x = pk2(v[j][0], v[j][1]); w.y = pk2(v[j][2], v[j][3]); st64((u32x2*)(XB + (size_t)t * D) + F.lane + 64 * j, w); }
                if (F.lane < 24) {
                    const float ang = (float)cpos * invf;
                    const double rev = (double)ang * 0.15915494309189535; const float fr = (float)(rev - __builtin_rint(rev));
                    const float cs = __builtin_amdgcn_cosf(fr), sn = __builtin_amdgcn_sinf(fr);
                    if (F.lane < 8) { st32f(COSP + (size_t)t * 8 + F.lane, cs); st32f(SINP + (size_t)t * 8 + F.lane, sn); }
                    else { st32f(COSM + (size_t)t * 16 + F.lane - 8, cs); st32f(SINM + (size_t)t * 16 + F.lane - 8, sn); }
                }
            }
        }
                } }
            }
            PH_END
        }
    }
#undef PH_BEGIN
#undef PH_END
}

constexpr int N_PHASES = 1 + NCHUNK * (DEPTH * 9);
#ifndef MK_MULTI
#define MK_MULTI 0
#endif

extern "C" void kernel_launch(void* const* d_in, const int* in_sizes, int n_in, void* d_out, int out_size, void* d_ws, size_t ws_size, hipStream_t stream) {
    static int grid = 0;
    if (grid == 0) {
        if (n_in != 31 || out_size != TT * D || ws_size < WS_END) { fprintf(stderr, "kernel_launch: unexpected shapes: n_in %d out %d ws %zu (need %zu)\n", n_in, out_size, ws_size, (size_t)WS_END); grid = -1; return; }
        int dev = 0, cus = 0, per_cu = 0;
        if (hipGetDevice(&dev) != hipSuccess || hipDeviceGetAttribute(&cus, hipDeviceAttributeMultiprocessorCount, dev) != hipSuccess) { grid = -1; return; }
        if (hipFuncSetAttribute((const void*)fwd_kernel, hipFuncAttributeMaxDynamicSharedMemorySize, LDS_BYTES) != hipSuccess) { fprintf(stderr, "kernel_launch: hipFuncSetAttribute failed\n"); grid = -1; return; }
        if (hipOccupancyMaxActiveBlocksPerMultiprocessor(&per_cu, (const void*)fwd_kernel, NW * 64, LDS_BYTES) != hipSuccess || per_cu < 1) fprintf(stderr, "kernel_launch: occupancy query says %d\n", per_cu);
        (void)hipGetLastError();
        grid = cus;
    }
    if (grid < 0) return;
    if (hipMemsetAsync((char*)d_ws + WS_CTL, 0, CTL_ZERO_BYTES, stream) != hipSuccess) return;
    Args a; memset(&a, 0, sizeof(a));
    for (int i = 0; i < 31; ++i) a.in[i] = (GAS const void*)d_in[i];
    a.out = (GAS float*)d_out; a.ws = (GAS unsigned char*)d_ws;
    for (int i = 0; i < 8; ++i) a.invf_p[i] = (float)pow(500000.0, -(double)(2 * i) / 16.0);
    for (int i = 0; i < 16; ++i) a.invf_m[i] = (float)pow(500000.0, -(double)(2 * i) / 32.0);
    for (int l = 0; l < 2; ++l) { a.lam_init[l] = (float)(0.8 - 0.6 * exp(-0.3 * l)); a.oml[l] = 1.0f - a.lam_init[l]; }
#if MK_MULTI
    for (int p = 0; p < N_PHASES; ++p) { a.ph_lo = p; a.ph_hi = p + 1; hipLaunchKernelGGL(fwd_kernel, dim3(grid), dim3(NW * 64), LDS_BYTES, stream, a); }
#else
    a.ph_lo = 0; a.ph_hi = N_PHASES; hipLaunchKernelGGL(fwd_kernel, dim3(grid), dim3(NW * 64), LDS_BYTES, stream, a);
#endif
    const hipError_t le = hipPeekAtLastError();
    if (le != hipSuccess) fprintf(stderr, "kernel_launch: launch failed: %s\n", hipGetErrorName(le));
}
```
